# Optimizing an MI355X kernel written in HIP

```python
import jax, jax.numpy as jnp
from jax import lax
import numpy as np

D_MODEL = 1024
BATCH = 1
SEQ = 16384
DEPTH = 4
DEC_BATCH = 16
DEC_SEQ = 4096
PAST_LEN = 128

N_MIXERS = 2
EPS = 1e-6
N_MEM = 256
MEM_HEADS = 4
MEM_HDIM = 64
MEM_WIDTH = MEM_HEADS * MEM_HDIM
MLA_HEADS = 12
QK_NOPE = 64
QK_ROPE = 32
QK_HEAD = QK_NOPE + QK_ROPE
V_HEAD = 64
Q_LORA = 384
KV_LORA = 256
MLA_WIDTH = MLA_HEADS * V_HEAD
ROPE_BASE = 10000.0
Q_BLOCK = 128
CHUNK = 128
SG_GROUPS = 8
SG_WIDTH = 768
SG_GDIM = SG_WIDTH // SG_GROUPS
BRANCH = MLA_WIDTH + MEM_WIDTH
IN_A = Q_LORA + KV_LORA + QK_ROPE + MEM_WIDTH + BRANCH
IN_B = 2 * SG_WIDTH + MEM_WIDTH + BRANCH
N_A = (DEPTH + 1) // 2
N_B = DEPTH // 2

kernel_name = 'hybrid_mla_sgu_memory_encoder'


def rmsnorm(x, g):
    xf = x.astype(jnp.float32)
    y = xf * lax.rsqrt(jnp.mean(xf * xf, axis=-1, keepdims=True) + EPS)
    return (y * g.astype(jnp.float32)).astype(x.dtype)


def rope_tables(seq):
    inv = 1.0 / (ROPE_BASE ** (jnp.arange(0, QK_ROPE, 2, dtype=jnp.float32) / QK_ROPE))
    ang = jnp.arange(seq, dtype=jnp.float32)[:, None] * inv[None, :]
    return jnp.cos(ang), jnp.sin(ang)


def apply_rope(x, cos, sin):
    x1, x2 = jnp.split(x, 2, axis=-1)
    c = cos[None, :, None, :]
    s = sin[None, :, None, :]
    return jnp.concatenate([x1 * c - x2 * s, x1 * s + x2 * c], axis=-1).astype(x.dtype)


def block_attention(q, k, v, scale):
    B, S, H, Dk = q.shape
    Dv = v.shape[-1]
    nb = S // Q_BLOCK
    qb = q.reshape(B, nb, Q_BLOCK, H, Dk).transpose(1, 0, 2, 3, 4)

    def one_block(qblk):
        s = jnp.einsum('bqhd,bkhd->bhqk', qblk, k, preferred_element_type=jnp.float32) * scale
        p = jax.nn.softmax(s, axis=-1)
        return jnp.einsum('bhqk,bkhd->bqhd', p.astype(v.dtype), v)

    o = lax.map(one_block, qb)
    return o.transpose(1, 0, 2, 3, 4).reshape(B, S, H * Dv)


def mla_mixer(q_lat, kv_lat, k_pe, cos, sin, qlat_g, kvlat_g, w_uq, w_ukv, q_norm_g, k_norm_g):
    B, S, _ = q_lat.shape
    q = (rmsnorm(q_lat, qlat_g) @ w_uq).reshape(B, S, MLA_HEADS, QK_HEAD)
    q = rmsnorm(q, q_norm_g)
    q = jnp.concatenate([q[..., :QK_NOPE], apply_rope(q[..., QK_NOPE:], cos, sin)], axis=-1)
    kv = (rmsnorm(kv_lat, kvlat_g) @ w_ukv).reshape(B, S, MLA_HEADS, QK_NOPE + V_HEAD)
    k_nope, v = kv[..., :QK_NOPE], kv[..., QK_NOPE:]
    k_pe_h = jnp.broadcast_to(k_pe[:, :, None, :], (B, S, MLA_HEADS, QK_ROPE))
    k = rmsnorm(jnp.concatenate([k_nope, k_pe_h], axis=-1), k_norm_g)
    k = jnp.concatenate([k[..., :QK_NOPE], apply_rope(k[..., QK_NOPE:], cos, sin)], axis=-1)
    return block_attention(q, k, v, QK_HEAD ** -0.5)


def sgu_mixer(uv, v_norm_g, w_s, b_s):
    B, S, _ = uv.shape
    uv = jax.nn.gelu(uv)
    u, v = uv[..., :SG_WIDTH], uv[..., SG_WIDTH:]
    v = rmsnorm(v, v_norm_g)
    vc = v.reshape(B, S // CHUNK, CHUNK, SG_GROUPS, SG_GDIM)
    mixed = jnp.einsum('gts,bcsgd->bctgd', w_s, vc) + b_s.T[None, None, :, :, None]
    return u * mixed.reshape(B, S, SG_WIDTH)


def memory_attention(q_mem, mem, mem_g, w_mem_kv, mq_g, mk_g):
    B, S, _ = q_mem.shape
    q = rmsnorm(q_mem.reshape(B, S, MEM_HEADS, MEM_HDIM), mq_g)
    kv = rmsnorm(mem, mem_g) @ w_mem_kv
    k = rmsnorm(kv[..., :MEM_WIDTH].reshape(B, N_MEM, MEM_HEADS, MEM_HDIM), mk_g)
    v = kv[..., MEM_WIDTH:].reshape(B, N_MEM, MEM_HEADS, MEM_HDIM)
    s = jnp.einsum('bqhd,bkhd->bhqk', q, k, preferred_element_type=jnp.float32) * (MEM_HDIM ** -0.5)
    p = jax.nn.softmax(s, axis=-1)
    o = jnp.einsum('bhqk,bkhd->bqhd', p.astype(v.dtype), v)
    return o.reshape(B, S, MEM_WIDTH)


def encoder_trunk(x, mem, ln_g, w_in_a, a_qlat_g, a_kvlat_g, a_w_uq, a_w_ukv, a_q_norm_g, a_k_norm_g,
                  w_in_b, b_v_norm_g, b_w_s, b_bias, mem_norm_g, w_mem_kv, mem_q_norm_g, mem_k_norm_g, w_out):
    S = x.shape[1]
    cos, sin = rope_tables(S)
    for i in range(DEPTH):
        h = rmsnorm(x, ln_g[i])
        j = i // N_MIXERS
        if i % N_MIXERS == 0:
            p = h @ w_in_a[j]
            q_lat, kv_lat, k_pe, q_mem, gate = jnp.split(
                p, [Q_LORA, Q_LORA + KV_LORA, Q_LORA + KV_LORA + QK_ROPE,
                    Q_LORA + KV_LORA + QK_ROPE + MEM_WIDTH], axis=-1)
            o_mix = mla_mixer(q_lat, kv_lat, k_pe, cos, sin, a_qlat_g[j], a_kvlat_g[j], a_w_uq[j],
                              a_w_ukv[j], a_q_norm_g[j], a_k_norm_g[j])
        else:
            p = h @ w_in_b[j]
            uv, q_mem, gate = jnp.split(p, [2 * SG_WIDTH, 2 * SG_WIDTH + MEM_WIDTH], axis=-1)
            o_mix = sgu_mixer(uv, b_v_norm_g[j], b_w_s[j], b_bias[j])
        o_mem = memory_attention(q_mem, mem, mem_norm_g[i], w_mem_kv[i], mem_q_norm_g[i], mem_k_norm_g[i])
        o = jnp.concatenate([o_mix, o_mem], axis=-1) * jax.nn.silu(gate)
        x = x + o @ w_out[i]
    return x


def setup_inputs(seed: int = 0) -> dict:
    key = jax.random.key(seed)
    ks = jax.random.split(key, 22)
    f = jnp.float32

    def nrm(k, shape, scale):
        return jax.random.normal(k, shape, f) * scale

    def gain(k, shape):
        return 1.0 + 0.02 * jax.random.normal(k, shape, f)

    return {
        'x_prompt': nrm(ks[0], (BATCH, SEQ, D_MODEL), 1.0),
        'x_sample': nrm(ks[1], (DEC_BATCH, DEC_SEQ, D_MODEL), 1.0),
        'mem_prompt': nrm(ks[2], (BATCH, N_MEM, D_MODEL), 1.0),
        'mem_sample': nrm(ks[3], (DEC_BATCH, N_MEM, D_MODEL), 1.0),
        'ln_g': gain(ks[4], (DEPTH, D_MODEL)),
        'w_in_a': nrm(ks[5], (N_A, D_MODEL, IN_A), D_MODEL ** -0.5),
        'a_qlat_g': gain(ks[6], (N_A, Q_LORA)),
        'a_kvlat_g': gain(ks[7], (N_A, KV_LORA)),
        'a_w_uq': nrm(ks[8], (N_A, Q_LORA, MLA_HEADS * QK_HEAD), Q_LORA ** -0.5),
        'a_w_ukv': nrm(ks[9], (N_A, KV_LORA, MLA_HEADS * (QK_NOPE + V_HEAD)), KV_LORA ** -0.5),
        'a_q_norm_g': gain(ks[10], (N_A, QK_HEAD)),
        'a_k_norm_g': gain(ks[11], (N_A, QK_HEAD)),
        'w_in_b': nrm(ks[12], (N_B, D_MODEL, IN_B), D_MODEL ** -0.5),
        'b_v_norm_g': gain(ks[13], (N_B, SG_WIDTH)),
        'b_w_s': nrm(ks[14], (N_B, SG_GROUPS, CHUNK, CHUNK), CHUNK ** -0.5),
        'b_bias': 1.0 + 0.1 * jax.random.normal(ks[15], (N_B, SG_GROUPS, CHUNK), f),
        'mem_norm_g': gain(ks[16], (DEPTH, D_MODEL)),
        'w_mem_kv': nrm(ks[17], (DEPTH, D_MODEL, 2 * MEM_WIDTH), D_MODEL ** -0.5),
        'mem_q_norm_g': gain(ks[18], (DEPTH, MEM_HDIM)),
        'mem_k_norm_g': gain(ks[19], (DEPTH, MEM_HDIM)),
        'w_out': nrm(ks[20], (DEPTH, BRANCH, D_MODEL), BRANCH ** -0.5),
    }


def reference(x_prompt, x_sample, mem_prompt, mem_sample, ln_g, w_in_a, a_qlat_g, a_kvlat_g, a_w_uq,
              a_w_ukv, a_q_norm_g, a_k_norm_g, w_in_b, b_v_norm_g, b_w_s, b_bias, mem_norm_g, w_mem_kv,
              mem_q_norm_g, mem_k_norm_g, w_out):
    y_prompt = encoder_trunk(x_prompt, mem_prompt, ln_g, w_in_a, a_qlat_g, a_kvlat_g, a_w_uq, a_w_ukv,
                             a_q_norm_g, a_k_norm_g, w_in_b, b_v_norm_g, b_w_s, b_bias, mem_norm_g,
                             w_mem_kv, mem_q_norm_g, mem_k_norm_g, w_out)
    y_sample = encoder_trunk(x_sample, mem_sample, ln_g, w_in_a, a_qlat_g, a_kvlat_g, a_w_uq, a_w_ukv,
                             a_q_norm_g, a_k_norm_g, w_in_b, b_v_norm_g, b_w_s, b_bias, mem_norm_g,
                             w_mem_kv, mem_q_norm_g, mem_k_norm_g, w_out)
    return (y_prompt, y_sample)
```

```cpp
#include <hip/hip_runtime.h>
#include <hip/hip_cooperative_groups.h>
#include <cstdio>
namespace cg = cooperative_groups;
#define DUPMASK 0

typedef __attribute__((ext_vector_type(8))) short bf16x8;
typedef __attribute__((ext_vector_type(16))) float f32x16;
typedef __attribute__((ext_vector_type(4))) float f32x4;
typedef __attribute__((ext_vector_type(4))) unsigned u32x4;
typedef __attribute__((ext_vector_type(2))) unsigned u32x2;
typedef __attribute__((ext_vector_type(2))) float f32x2;
typedef __attribute__((ext_vector_type(2))) __bf16 bf16x2_t;

#define DI __device__ __forceinline__
#define MFMA(a, b, c) __builtin_amdgcn_mfma_f32_32x32x16_bf16((a), (b), (c), 0, 0, 0)

constexpr int T = 81920;
constexpr int TP = 16384;
constexpr int SS = 4096;
constexpr int NSEQ = 17;
constexpr int MEMROWS = NSEQ * 256;
constexpr float EPS = 1e-6f;
constexpr float LOG2E = 1.4426950408889634f;

constexpr size_t SZ_WIA = (size_t)2 * 2048 * 1024 * 2;
constexpr size_t SZ_WIB = (size_t)2 * 2816 * 1024 * 2;
constexpr size_t SZ_WUQ = (size_t)2 * 1152 * 384 * 2;
constexpr size_t SZ_WUKV = (size_t)2 * 1536 * 256 * 2;
constexpr size_t SZ_WMKV = (size_t)4 * 512 * 1024 * 2;
constexpr size_t SZ_WOUT = (size_t)4 * 1024 * 1024 * 2;
constexpr size_t SZ_WS = (size_t)2 * 8 * 128 * 128 * 2;
constexpr size_t OFF_WIA = 0;
constexpr size_t OFF_WIB = OFF_WIA + SZ_WIA;
constexpr size_t OFF_WUQ = OFF_WIB + SZ_WIB;
constexpr size_t OFF_WUKV = OFF_WUQ + SZ_WUQ;
constexpr size_t OFF_WMKV = OFF_WUKV + SZ_WUKV;
constexpr size_t OFF_WOUT = OFF_WMKV + SZ_WMKV;
constexpr size_t OFF_WS = OFF_WOUT + SZ_WOUT;
constexpr size_t OFF_SSQ = OFF_WS + SZ_WS;
constexpr size_t OFF_SSQM = OFF_SSQ + (size_t)10 * T * 4;
constexpr size_t OFF_KMEM = OFF_SSQM + 32768;
constexpr size_t SZ_KMEM = (size_t)4 * MEMROWS * 256 * 2;
constexpr size_t OFF_VMEM = OFF_KMEM + SZ_KMEM;
constexpr size_t OFF_MEMB = OFF_VMEM + SZ_KMEM;
constexpr size_t OFF_O = OFF_MEMB + (size_t)MEMROWS * 1024 * 2;
constexpr size_t OFF_QLAT = OFF_O;
constexpr size_t OFF_KVLAT = OFF_QLAT + (size_t)T * 384 * 2;
constexpr size_t OFF_KPE = OFF_KVLAT + (size_t)T * 256 * 2;
constexpr size_t OFF_Q = OFF_O + (size_t)T * 1024 * 2;
constexpr size_t OFF_XB = OFF_Q;
constexpr size_t OFF_K = OFF_Q + (size_t)T * 1152 * 2;
constexpr size_t OFF_VT = OFF_K + (size_t)T * 1152 * 2;
constexpr size_t OFF_U = OFF_VT;
constexpr size_t OFF_QMEM = OFF_VT + (size_t)T * 768 * 2;
constexpr size_t OFF_GATE = OFF_QMEM + (size_t)T * 256 * 2;
constexpr size_t WS_TOTAL = OFF_GATE + (size_t)T * 1024 * 2;

struct Params {
  const float* in[21];
  float* out;
  char* ws;
};

typedef const __attribute__((address_space(4))) Params& PRef;

DI unsigned pack_bf16(float a, float b) {
  f32x2 v = {a, b};
  bf16x2_t r = __builtin_convertvector(v, bf16x2_t);
  return __builtin_bit_cast(unsigned, r);
}
DI int my_tid() { int t = threadIdx.x; asm volatile("" : "+v"(t)); return t; }
DI float bf_lo(unsigned u) { return __uint_as_float(u << 16); }
DI float bf_hi(unsigned u) { return __uint_as_float(u & 0xffff0000u); }
DI float rsqrt_f(float x) { return __builtin_amdgcn_rsqf(x); }
DI float exp2_f(float x) { return __builtin_amdgcn_exp2f(x); }
DI float silu_f(float x) { return x * __builtin_amdgcn_rcpf(1.f + exp2_f(-x * LOG2E)); }
DI float gelu_f(float x) {
  float u = 0.7978845608028654f * (x + 0.044715f * x * x * x);
  return x * __builtin_amdgcn_rcpf(1.f + exp2_f(-2.f * LOG2E * u));
}
DI void atomic_add_f(float* p, float v) { __hip_atomic_fetch_add(p, v, __ATOMIC_RELAXED, __HIP_MEMORY_SCOPE_AGENT); }

__device__ const double ROPE_TURNS[16] = {
  0.15915494309189535, 0.08949887106850354, 0.05032921210448704, 0.028302194144593214,
  0.015915494309189534, 0.008949887106850355, 0.005032921210448704, 0.0028302194144593215,
  0.0015915494309189536, 0.0008949887106850354, 0.0005032921210448704, 0.00028302194144593214,
  0.00015915494309189535, 8.949887106850354e-05, 5.032921210448704e-05, 2.8302194144593215e-05};
DI void rope_cs(int pos, int i, float& c, float& s) {
  double t = (double)pos * ROPE_TURNS[i];
  t -= floor(t);
  float fr = (float)t;
  s = __builtin_amdgcn_sinf(fr);
  c = __builtin_amdgcn_cosf(fr);
}
DI int tok_pos(int tok) { return tok < TP ? tok : ((tok - TP) & (SS - 1)); }
DI int tok_seq(int tok) { return tok < TP ? 0 : 1 + ((tok - TP) >> 12); }

constexpr int LROW = 144;
constexpr int STAGE_BYTES = 2 * 128 * LROW;
constexpr int SF_BYTES = 128 * 132 * 4;
constexpr int SMEM_BYTES = 2 * SF_BYTES;
constexpr int SF_LD = 132;

#define RAW_BARRIER() do { asm volatile("s_waitcnt lgkmcnt(0)" ::: "memory"); __builtin_amdgcn_s_barrier(); } while (0)
#define WAIT_VM(n) asm volatile("s_waitcnt vmcnt(" #n ")" ::: "memory")

constexpr int GBK = 32;
constexpr int GSTAGE = 32768;
constexpr int GBOFF = 16384;
template <bool AF32>
DI void gemm_main(const void* Ap, int lda, const short* Bp, int K, char* smem, f32x16 (&acc)[4][2]) {
  const int tid = my_tid(), lane = tid & 63, w = tid >> 6, r = lane & 31, h = lane >> 5;
  const int wm = w >> 2, wn = w & 3;
#pragma unroll
  for (int a = 0; a < 4; a++)
#pragma unroll
    for (int b = 0; b < 2; b++)
#pragma unroll
      for (int i = 0; i < 16; i++) acc[a][b][i] = 0.f;

  const int lch = (lane & 3) ^ ((lane >> 4) & 3);
  const short* ga = (const short*)Ap + (size_t)(w * 32 + (lane >> 2)) * lda + lch * 8;
  const short* gb = Bp + (size_t)(w * 32 + (lane >> 2)) * K + lch * 8;
  const size_t a16 = (size_t)16 * lda, b16 = (size_t)16 * K;
  char* lbase = smem + w * 2048;
#define GLDS(kt, slot)                                                                                                     \
  {                                                                                                                        \
    char* l_ = lbase + (slot) * GSTAGE;                                                                                    \
    __builtin_amdgcn_global_load_lds((const unsigned*)(ga + (kt) * GBK), (unsigned*)(l_), 16, 0, 0);                       \
    __builtin_amdgcn_global_load_lds((const unsigned*)(ga + a16 + (kt) * GBK), (unsigned*)(l_ + 1024), 16, 0, 0);          \
    __builtin_amdgcn_global_load_lds((const unsigned*)(gb + (kt) * GBK), (unsigned*)(l_ + GBOFF), 16, 0, 0);               \
    __builtin_amdgcn_global_load_lds((const unsigned*)(gb + b16 + (kt) * GBK), (unsigned*)(l_ + GBOFF + 1024), 16, 0, 0);  \
  }
  const int x = (r >> 2) & 3;
  const int off0 = ((h ^ x) << 4);
  const int aoff = (wm * 128 + r) * 64, boff = GBOFF + (wn * 64 + r) * 64;
  struct Frag { bf16x8 a[4], b0, b1; };
#define LOADF(F, slot, ks)                                                                  \
  {                                                                                         \
    const char* sa_ = smem + (slot) * GSTAGE + aoff + (off0 ^ ((ks) << 5));                 \
    const char* sb_ = smem + (slot) * GSTAGE + boff + (off0 ^ ((ks) << 5));                 \
    F.b0 = *(const bf16x8*)(sb_);                                                           \
    F.b1 = *(const bf16x8*)(sb_ + 2048);                                                    \
    _Pragma("unroll") for (int mi = 0; mi < 4; mi++) F.a[mi] = *(const bf16x8*)(sa_ + mi * 2048); \
  }
#define MM(F)                                                                               \
  {                                                                                         \
    _Pragma("unroll") for (int mi = 0; mi < 4; mi++) {                                      \
      acc[mi][0] = MFMA(F.a[mi], F.b0, acc[mi][0]);                                         \
      acc[mi][1] = MFMA(F.a[mi], F.b1, acc[mi][1]);                                         \
    }                                                                                       \
  }
  const int nk = K >> 5;
  Frag F0, F1;
  GLDS(0, 0);
  GLDS(1, 1);
  GLDS(2, 2);
  GLDS(3, 3);
  WAIT_VM(12);
  RAW_BARRIER();
  LOADF(F0, 0, 0);
  for (int kt = 0; kt < nk - 3; kt++) {
    LOADF(F1, kt & 3, 1);
    MM(F0);
    WAIT_VM(8);
    RAW_BARRIER();
    if (kt + 4 < nk) GLDS(kt + 4, kt & 3);
    LOADF(F0, (kt + 1) & 3, 0);
    MM(F1);
  }
  LOADF(F1, (nk - 3) & 3, 1);
  MM(F0);
  WAIT_VM(4);
  RAW_BARRIER();
  LOADF(F0, (nk - 2) & 3, 0);
  MM(F1);
  LOADF(F1, (nk - 2) & 3, 1);
  MM(F0);
  WAIT_VM(0);
  RAW_BARRIER();
  LOADF(F0, (nk - 1) & 3, 0);
  MM(F1);
  LOADF(F1, (nk - 1) & 3, 1);
  MM(F0);
  MM(F1);
  __syncthreads();
#undef LOADF
#undef MM
#undef GLDS
}

DI void stage_half(const f32x16 (&acc)[4][2], int pm, char* smem) {
  const int tid = my_tid(), lane = tid & 63, w = tid >> 6, r = lane & 31, h = lane >> 5;
  const int wm = w >> 2, wn = w & 3;
  float* sf = (float*)(smem + (wn >> 1) * SF_BYTES);
  if (wm == pm) {
#pragma unroll
    for (int mi = 0; mi < 4; mi++)
#pragma unroll
      for (int ni = 0; ni < 2; ni++)
#pragma unroll
        for (int i = 0; i < 16; i++) {
          int row = mi * 32 + (i & 3) + 8 * (i >> 2) + 4 * h;
          int col = (wn & 1) * 64 + ni * 32 + r;
          sf[row * SF_LD + col] = acc[mi][ni][i];
        }
  }
  __syncthreads();
}

enum { EPI_BF16 = 0, EPI_BF16_SSQ, EPI_QMEM, EPI_GATE, EPI_KPE, EPI_KV, EPI_OUT, EPI_U, EPI_VT, EPI_MEMK, EPI_MEMV, EPI_NONE };

struct Epi {
  int type;
  int m0;
  short* dst;
  int ld;
  int col0;
  const float* ssq_in;
  float inv_k;
  float* ssq_out;
  const float* g;
  const float* kpe;
  short* kdst;
  short* vtdst;
  int head;
  const float* xold;
  const short* xoldb;
  float* xnew;
  float* fdst;
};

DI void store8_bf16(short* p, const float (&v)[8]) {
  u32x4 o;
  o[0] = pack_bf16(v[0], v[1]); o[1] = pack_bf16(v[2], v[3]); o[2] = pack_bf16(v[4], v[5]); o[3] = pack_bf16(v[6], v[7]);
  __builtin_nontemporal_store(o, (u32x4*)p);
}
DI float red8(float x) { x += __shfl_xor(x, 1); x += __shfl_xor(x, 2); x += __shfl_xor(x, 4); return x; }
DI float red16(float x) { x = red8(x); x += __shfl_xor(x, 8); return x; }

DI void tstore(const float* sf, int c0, int ncols, short* dst, size_t ldt) {
  for (int idx = my_tid() & 255; idx < ncols * 16; idx += 256) {
    int tg4 = idx & 3, c = (idx >> 2) % ncols, tgh = idx / (4 * ncols);
    int t0 = (tgh * 4 + tg4) * 8;
    const float* sp = sf + t0 * SF_LD + c0 + c;
    u32x4 o;
#pragma unroll
    for (int e = 0; e < 4; e++) o[e] = pack_bf16(sp[(2 * e) * SF_LD], sp[(2 * e + 1) * SF_LD]);
    *(u32x4*)(dst + (size_t)c * ldt + t0) = o;
  }
}

template <int TYPE>
DI void epi_rows(const Epi& e, float* sf, const u32x4 (&pre)[8], bool use_pre) {
  const int tid = my_tid() & 255, lane = tid & 63, w = tid >> 6;
  const int c8 = lane & 15, rsub = lane >> 4;
  const int q = c8 - 8;
#pragma unroll
  for (int bt = 0; bt < 2; bt++) {
    float ssq[4];
    f32x4 xo[4][2];
    f32x2 pea[4], peb[4];
    float gv[8];
#pragma unroll
    for (int s4 = 0; s4 < 4; s4++) {
      const int row = w * 32 + (bt * 4 + s4) * 4 + rsub;
      const int grow = e.m0 + row;
      ssq[s4] = (use_pre && TYPE != EPI_OUT) ? __uint_as_float(pre[bt * 4 + s4][0]) : (e.ssq_in ? e.ssq_in[grow] : 0.f);
      if (TYPE == EPI_OUT) {
        if (e.xoldb) {
          const u32x4 t = use_pre ? pre[bt * 4 + s4] : *(const u32x4*)(e.xoldb + (size_t)grow * 1024 + e.col0 + c8 * 8);
          xo[s4][0] = f32x4{bf_lo(t[0]), bf_hi(t[0]), bf_lo(t[1]), bf_hi(t[1])};
          xo[s4][1] = f32x4{bf_lo(t[2]), bf_hi(t[2]), bf_lo(t[3]), bf_hi(t[3])};
        } else {
          const float* xp = e.xold + (size_t)row * 1024 + e.col0 + c8 * 8;
          xo[s4][0] = *(const f32x4*)xp;
          xo[s4][1] = *(const f32x4*)(xp + 4);
        }
      }
      if (TYPE == EPI_KV) {
        const float* pp = e.kpe + (size_t)grow * 32 + 2 * (q & 7);
        pea[s4] = *(const f32x2*)pp;
        peb[s4] = *(const f32x2*)(pp + 16);
      }
    }
    if (TYPE == EPI_QMEM || TYPE == EPI_MEMK) {
#pragma unroll
      for (int c = 0; c < 8; c++) gv[c] = e.g[(c8 & 7) * 8 + c];
    }
    if (TYPE == EPI_KV) {
#pragma unroll
      for (int c = 0; c < 8; c++) gv[c] = e.g[(c8 & 7) * 8 + c];
    }
#pragma unroll
    for (int s4 = 0; s4 < 4; s4++) {
      const int row = w * 32 + (bt * 4 + s4) * 4 + rsub;
      const int grow = e.m0 + row;
      const float rs = e.ssq_in ? rsqrt_f(ssq[s4] * e.inv_k + EPS) : 1.f;
      float* rp = sf + row * SF_LD + c8 * 8;
      float v[8];
      {
        f32x4 t0 = *(const f32x4*)rp, t1 = *(const f32x4*)(rp + 4);
        v[0] = t0[0] * rs; v[1] = t0[1] * rs; v[2] = t0[2] * rs; v[3] = t0[3] * rs;
        v[4] = t1[0] * rs; v[5] = t1[1] * rs; v[6] = t1[2] * rs; v[7] = t1[3] * rs;
      }
      if (TYPE == EPI_BF16 || TYPE == EPI_BF16_SSQ || TYPE == EPI_GATE || TYPE == EPI_U) {
        if (TYPE == EPI_BF16_SSQ) {
          float ss = 0.f;
#pragma unroll
          for (int c = 0; c < 8; c++) ss += v[c] * v[c];
          ss = red16(ss);
          if (c8 == 0 && e.ssq_out) atomic_add_f(e.ssq_out + grow, ss);
        } else if (TYPE == EPI_GATE) {
#pragma unroll
          for (int c = 0; c < 8; c++) v[c] = silu_f(v[c]);
        } else if (TYPE == EPI_U) {
#pragma unroll
          for (int c = 0; c < 8; c++) v[c] = gelu_f(v[c]);
        }
        store8_bf16(e.dst + (size_t)grow * e.ld + e.col0 + c8 * 8, v);
      } else if (TYPE == EPI_QMEM || TYPE == EPI_MEMK) {
        float ss = 0.f;
#pragma unroll
        for (int c = 0; c < 8; c++) ss += v[c] * v[c];
        ss = red8(ss);
        float f = rsqrt_f(ss * (1.f / 64.f) + EPS);
        if (TYPE == EPI_QMEM) f *= 0.125f * LOG2E;
#pragma unroll
        for (int c = 0; c < 8; c++) v[c] *= f * gv[c];
        short* d = TYPE == EPI_MEMK ? e.dst + (size_t)(c8 >> 3) * 256 * 64 + (size_t)row * 64 + (c8 & 7) * 8
                                    : e.dst + (size_t)grow * e.ld + e.col0 + c8 * 8;
        store8_bf16(d, v);
      } else if (TYPE == EPI_KPE) {
        if (c8 < 4) {
          float* d = e.fdst + (size_t)grow * 32 + c8 * 8;
          f32x4 t0 = {v[0], v[1], v[2], v[3]}, t1 = {v[4], v[5], v[6], v[7]};
          *(f32x4*)d = t0;
          *(f32x4*)(d + 4) = t1;
        }
      } else if (TYPE == EPI_OUT) {
        f32x4 t0 = xo[s4][0], t1 = xo[s4][1];
        t0[0] += v[0]; t0[1] += v[1]; t0[2] += v[2]; t0[3] += v[3];
        t1[0] += v[4]; t1[1] += v[5]; t1[2] += v[6]; t1[3] += v[7];
        if (e.xnew) {
          float* xn = e.xnew + (size_t)grow * 1024 + e.col0 + c8 * 8;
          *(f32x4*)xn = t0;
          *(f32x4*)(xn + 4) = t1;
        }
        float ss = t0[0] * t0[0] + t0[1] * t0[1] + t0[2] * t0[2] + t0[3] * t0[3] + t1[0] * t1[0] + t1[1] * t1[1] + t1[2] * t1[2] + t1[3] * t1[3];
        if (e.dst) {
          float xv[8] = {t0[0], t0[1], t0[2], t0[3], t1[0], t1[1], t1[2], t1[3]};
          store8_bf16(e.dst + (size_t)grow * 1024 + e.col0 + c8 * 8, xv);
        }
        ss = red16(ss);
        if (c8 == 0 && e.ssq_out) atomic_add_f(e.ssq_out + grow, ss);
      } else if (TYPE == EPI_VT || TYPE == EPI_MEMV) {
        float ss = 0.f;
#pragma unroll
        for (int c = 0; c < 8; c++) {
          if (TYPE == EPI_VT) v[c] = gelu_f(v[c]);
          ss += v[c] * v[c];
        }
        f32x4 t0 = {v[0], v[1], v[2], v[3]}, t1 = {v[4], v[5], v[6], v[7]};
        *(f32x4*)rp = t0;
        *(f32x4*)(rp + 4) = t1;
        if (TYPE == EPI_VT) {
          ss = red16(ss);
          if (c8 == 0 && e.ssq_out) atomic_add_f(e.ssq_out + grow, ss);
        }
      } else {
        float ss = 0.f;
        if (c8 < 8) {
#pragma unroll
          for (int c = 0; c < 8; c++) ss += v[c] * v[c];
        } else {
          f32x4 t0 = {v[0], v[1], v[2], v[3]}, t1 = {v[4], v[5], v[6], v[7]};
          *(f32x4*)rp = t0;
          *(f32x4*)(rp + 4) = t1;
          ss = pea[s4][0] * pea[s4][0] + pea[s4][1] * pea[s4][1] + peb[s4][0] * peb[s4][0] + peb[s4][1] * peb[s4][1];
        }
        ss = red16(ss);
        const float f = rsqrt_f(ss * (1.f / 96.f) + EPS);
        short* kd = e.kdst + ((size_t)e.head * T + grow) * 96;
        if (c8 < 8) {
#pragma unroll
          for (int c = 0; c < 8; c++) v[c] *= f * gv[c];
          store8_bf16(kd + c8 * 8, v);
        } else {
          const int pos = tok_pos(grow);
          float o1[2], o2[2];
#pragma unroll
          for (int t = 0; t < 2; t++) {
            int i = 2 * q + t;
            float cs, sn;
            rope_cs(pos, i, cs, sn);
            float x1 = pea[s4][t] * f * e.g[64 + i], x2 = peb[s4][t] * f * e.g[80 + i];
            o1[t] = x1 * cs - x2 * sn;
            o2[t] = x1 * sn + x2 * cs;
          }
          *(unsigned*)(kd + 64 + 2 * q) = pack_bf16(o1[0], o1[1]);
          *(unsigned*)(kd + 80 + 2 * q) = pack_bf16(o2[0], o2[1]);
        }
      }
    }
  }
}

DI void gemm_epilogue(const Epi& e, char* smem, const u32x4 (&pre)[8], bool use_pre);
DI void gemm_epilogue(const Epi& e, char* smem) {
  u32x4 none[8];
#pragma unroll
  for (int i = 0; i < 8; i++) none[i] = u32x4{0u, 0u, 0u, 0u};
  gemm_epilogue(e, smem, none, false);
}
DI void gemm_epilogue(const Epi& e, char* smem, const u32x4 (&pre)[8], bool use_pre) {
  float* sf = (float*)(smem + ((my_tid() >> 8) & 1) * SF_BYTES);
  const int type = e.type;
  switch (type) {
    case EPI_BF16: epi_rows<EPI_BF16>(e, sf, pre, use_pre); break;
    case EPI_BF16_SSQ: epi_rows<EPI_BF16_SSQ>(e, sf, pre, use_pre); break;
    case EPI_QMEM: epi_rows<EPI_QMEM>(e, sf, pre, use_pre); break;
    case EPI_GATE: epi_rows<EPI_GATE>(e, sf, pre, use_pre); break;
    case EPI_KPE: epi_rows<EPI_KPE>(e, sf, pre, use_pre); break;
    case EPI_KV: epi_rows<EPI_KV>(e, sf, pre, use_pre); break;
    case EPI_OUT: epi_rows<EPI_OUT>(e, sf, pre, use_pre); break;
    case EPI_U: epi_rows<EPI_U>(e, sf, pre, use_pre); break;
    case EPI_VT: epi_rows<EPI_VT>(e, sf, pre, use_pre); break;
    case EPI_MEMK: epi_rows<EPI_MEMK>(e, sf, pre, use_pre); break;
    case EPI_MEMV: epi_rows<EPI_MEMV>(e, sf, pre, use_pre); break;
    default: break;
  }
  __syncthreads();
  if (type == EPI_KV) tstore(sf, 64, 64, e.vtdst + (size_t)e.head * 64 * T + e.m0, (size_t)T);
  else if (type == EPI_VT) tstore(sf, 0, 128, e.dst + (size_t)e.col0 * T + e.m0, (size_t)T);
  else if (type == EPI_MEMV) tstore(sf, 0, 128, e.dst, 256);
  __syncthreads();
}

#define SGB(mask, n) __builtin_amdgcn_sched_group_barrier((mask), (n), 0)
template <int DK>
DI void attn_core(const bf16x8 (&qf)[DK / 16], const short* Kg, const short* VTg, size_t ldvt, int ntiles, char* smem,
                  f32x16 (&O)[2], float& lsum) {
  constexpr int KROW = DK * 2 + 16;
  constexpr int KT_BYTES = 128 * KROW;
  constexpr int VROW = 272;
  constexpr int ST = KT_BYTES + 64 * VROW;
  constexpr int KCH = DK / 8;
  constexpr int NKC = 128 * KCH / 512;
  constexpr int NKS = DK / 16;
  const int tid = my_tid(), lane = tid & 63, r = lane & 31, h = lane >> 5;
  const int pr = (r & ~12) | ((r & 4) << 1) | ((r & 8) >> 1);
  u32x4 kreg[NKC], vreg[2];
  int koff[NKC];
#pragma unroll
  for (int i = 0; i < NKC; i++) { int c = tid + 512 * i; koff[i] = (c / KCH) * KROW + (c % KCH) * 16; }
  const int vrow = tid >> 4, vcol = tid & 15;
  const short* vg = VTg + (size_t)vrow * ldvt + vcol * 8;
  const int voff = KT_BYTES + vrow * VROW + vcol * 16;
#pragma unroll
  for (int i = 0; i < 16; i++) { O[0][i] = 0.f; O[1][i] = 0.f; }
  float l0 = 0.f;

#define AGLOAD(t)                                                                              \
  {                                                                                            \
    _Pragma("unroll") for (int i = 0; i < NKC; i++) kreg[i] = *(const u32x4*)(Kg + (size_t)(t) * 128 * DK + (tid + 512 * i) * 8); \
    _Pragma("unroll") for (int i = 0; i < 2; i++) vreg[i] = *(const u32x4*)(vg + (size_t)(32 * i) * ldvt + (t) * 128); \
  }
#define ASTORE(s)                                                                              \
  {                                                                                            \
    char* sk_ = smem + (s) * ST;                                                               \
    _Pragma("unroll") for (int i = 0; i < NKC; i++) *(u32x4*)(sk_ + koff[i]) = kreg[i];        \
    _Pragma("unroll") for (int i = 0; i < 2; i++) *(u32x4*)(sk_ + voff + 32 * i * VROW) = vreg[i]; \
  }
#define SOFTMAX(S, pa, pb, lacc)                                                               \
  {                                                                                            \
    float p_[16];                                                                              \
    _Pragma("unroll") for (int i = 0; i < 16; i++) { p_[i] = exp2_f(S[i]); lacc += p_[i]; }   \
    u32x4 a_, b_;                                                                              \
    _Pragma("unroll") for (int q = 0; q < 4; q++) { a_[q] = pack_bf16(p_[2 * q], p_[2 * q + 1]); b_[q] = pack_bf16(p_[8 + 2 * q], p_[8 + 2 * q + 1]); } \
    pa = __builtin_bit_cast(bf16x8, a_);                                                       \
    pb = __builtin_bit_cast(bf16x8, b_);                                                       \
  }
#define KLOAD(kf_, base)                                                                       \
  { _Pragma("unroll") for (int ks = 0; ks < NKS; ks++) kf_[ks] = *(const bf16x8*)((base) + kfo + ks * 32); }
#define VLOAD(vf_, base)                                                                       \
  { _Pragma("unroll") for (int q = 0; q < 4; q++) vf_[q] = *(const bf16x8*)((base) + vfo + (q >> 1) * 32 * VROW + (q & 1) * 32); }
#define QKM(dst, kf_)                                                                          \
  {                                                                                            \
    _Pragma("unroll") for (int i = 0; i < 16; i++) dst[i] = 0.f;                               \
    _Pragma("unroll") for (int ks = 0; ks < NKS; ks++) dst = MFMA(kf_[ks], qf[ks], dst);       \
  }
#define PVM(vf_, pa, pb)                                                                       \
  {                                                                                            \
    O[0] = MFMA(vf_[0], pa, O[0]);                                                             \
    O[1] = MFMA(vf_[2], pa, O[1]);                                                             \
    O[0] = MFMA(vf_[1], pb, O[0]);                                                             \
    O[1] = MFMA(vf_[3], pb, O[1]);                                                             \
  }
#define SB() __builtin_amdgcn_sched_barrier(0)
  const int kfo = pr * KROW + h * 16;
  const int vfo = KT_BYTES + r * VROW + h * 16;
  AGLOAD(0);
  ASTORE(0);
  AGLOAD(ntiles > 1 ? 1 : 0);
  ASTORE(1);
  __syncthreads();
  f32x16 Sc;
  {
    bf16x8 kf[NKS];
    KLOAD(kf, smem);
    QKM(Sc, kf);
  }
  int sc = 0, sn = 1, sw = 2;
  for (int t = 0; t < ntiles; t++) {
    const int tn = t + 2 < ntiles ? t + 2 : ntiles - 1;
    AGLOAD(tn);
    const char* cur = smem + sc * ST;
    const char* nxt = smem + sn * ST;
    f32x16 Sn;
    bf16x8 pa, pb, qa, qb;
    bf16x8 kf[NKS], vf[4];
    KLOAD(kf, cur + 32 * KROW);
    SB();
    SOFTMAX(Sc, pa, pb, l0);
    SB();
    QKM(Sn, kf);
    SB();
    KLOAD(kf, cur + 64 * KROW);
    VLOAD(vf, cur);
    SB();
    SOFTMAX(Sn, qa, qb, l0);
    SB();
    QKM(Sc, kf);
    PVM(vf, pa, pb);
    SB();
    KLOAD(kf, cur + 96 * KROW);
    VLOAD(vf, cur + 64);
    SB();
    SOFTMAX(Sc, pa, pb, l0);
    SB();
    QKM(Sn, kf);
    PVM(vf, qa, qb);
    SB();
    KLOAD(kf, nxt);
    VLOAD(vf, cur + 128);
    SB();
    SOFTMAX(Sn, qa, qb, l0);
    SB();
    QKM(Sc, kf);
    PVM(vf, pa, pb);
    SB();
    VLOAD(vf, cur + 192);
    PVM(vf, qa, qb);
    ASTORE(sw);
    __syncthreads();
    const int tmp = sc; sc = sn; sn = sw; sw = tmp;
  }
  lsum = l0;
#undef AGLOAD
#undef ASTORE
#undef SOFTMAX
#undef KLOAD
#undef VLOAD
#undef QKM
#undef PVM
#undef SB
}

DI void attn_store(const f32x16 (&O)[2], float lsum, int tok, int col0, const short* gate, short* o, char* smem) {
  const int tid = my_tid(), lane = tid & 63, w = tid >> 6, r = lane & 31, h = lane >> 5;
  float l = lsum + __shfl_xor(lsum, 32);
  float inv = __builtin_amdgcn_rcpf(l);
  float* pw = (float*)(smem + w * (32 * 68 * 4));
#pragma unroll
  for (int dt = 0; dt < 2; dt++)
#pragma unroll
    for (int q = 0; q < 4; q++) {
      f32x4 t = {O[dt][q * 4 + 0] * inv, O[dt][q * 4 + 1] * inv, O[dt][q * 4 + 2] * inv, O[dt][q * 4 + 3] * inv};
      *(f32x4*)(pw + r * 68 + dt * 32 + 8 * q + 4 * h) = t;
    }
  asm volatile("s_waitcnt lgkmcnt(0)" ::: "memory");
  const int tokw = tok - r;
  const int ch = lane & 7;
#pragma unroll
  for (int j = 0; j < 4; j++) {
    const int row = j * 8 + (lane >> 3);
    const size_t g = (size_t)(tokw + row) * 1024 + col0 + ch * 8;
    const u32x4 gv = *(const u32x4*)(gate + g);
    const f32x4 a = *(const f32x4*)(pw + row * 68 + ch * 8), c = *(const f32x4*)(pw + row * 68 + ch * 8 + 4);
    u32x4 ov;
    ov[0] = pack_bf16(a[0] * bf_lo(gv[0]), a[1] * bf_hi(gv[0]));
    ov[1] = pack_bf16(a[2] * bf_lo(gv[1]), a[3] * bf_hi(gv[1]));
    ov[2] = pack_bf16(c[0] * bf_lo(gv[2]), c[1] * bf_hi(gv[2]));
    ov[3] = pack_bf16(c[2] * bf_lo(gv[3]), c[3] * bf_hi(gv[3]));
    __builtin_nontemporal_store(ov, (u32x4*)(o + g));
  }
  __syncthreads();
}

DI void mla_item(PRef p, int j, int seq, int head, int qb, char* smem) {
  const int tid = my_tid(), lane = tid & 63, w = tid >> 6, r = lane & 31, h = lane >> 5;
  const int s0 = seq == 0 ? 0 : TP + (seq - 1) * SS;
  const int S = seq == 0 ? TP : SS;
  const int pos = qb * 256 + w * 32 + r;
  const int tok = s0 + pos;
  const short* Q = (const short*)(p.ws + OFF_Q);
  const float* gq = p.in[10] + j * 96;
  float qv[6][8];
  float ss = 0.f;
#pragma unroll
  for (int ks = 0; ks < 6; ks++) {
    u32x4 t = *(const u32x4*)(Q + (size_t)tok * 1152 + head * 96 + ks * 16 + 8 * h);
#pragma unroll
    for (int e = 0; e < 4; e++) {
      qv[ks][2 * e] = bf_lo(t[e]);
      qv[ks][2 * e + 1] = bf_hi(t[e]);
    }
#pragma unroll
    for (int e = 0; e < 8; e++) ss += qv[ks][e] * qv[ks][e];
  }
  ss += __shfl_xor(ss, 32);
  const float f = rsqrt_f(ss * (1.f / 96.f) + EPS);
  const float sc = 0.10206207261596575f * LOG2E;
#pragma unroll
  for (int ks = 0; ks < 6; ks++)
#pragma unroll
    for (int e = 0; e < 8; e++) qv[ks][e] *= f * gq[ks * 16 + 8 * h + e];
#pragma unroll
  for (int e = 0; e < 8; e++) {
    float cs, sn;
    rope_cs(pos, 8 * h + e, cs, sn);
    float x1 = qv[4][e], x2 = qv[5][e];
    qv[4][e] = x1 * cs - x2 * sn;
    qv[5][e] = x1 * sn + x2 * cs;
  }
  bf16x8 qf[6];
#pragma unroll
  for (int ks = 0; ks < 6; ks++) {
    u32x4 t;
#pragma unroll
    for (int e = 0; e < 4; e++) t[e] = pack_bf16(qv[ks][2 * e] * sc, qv[ks][2 * e + 1] * sc);
    qf[ks] = __builtin_bit_cast(bf16x8, t);
  }
  f32x16 O[2];
  float lsum;
  const short* Kg = (const short*)(p.ws + OFF_K) + ((size_t)head * T + s0) * 96;
  const short* VTg = (const short*)(p.ws + OFF_VT) + (size_t)head * 64 * T + s0;
  attn_core<96>(qf, Kg, VTg, (size_t)T, S >> 7, smem, O, lsum);
  attn_store(O, lsum, tok, head * 64, (const short*)(p.ws + OFF_GATE), (short*)(p.ws + OFF_O), smem);
}

DI void memattn_item(PRef p, int layer, int mt, int head, char* smem) {
  const int tid = my_tid(), lane = tid & 63, w = tid >> 6, r = lane & 31, h = lane >> 5;
  const int tok = mt * 256 + w * 32 + r;
  const int seq = tok_seq(mt * 256);
  const short* Q = (const short*)(p.ws + OFF_QMEM);
  bf16x8 qf[4];
#pragma unroll
  for (int ks = 0; ks < 4; ks++) qf[ks] = *(const bf16x8*)(Q + (size_t)tok * 256 + head * 64 + ks * 16 + 8 * h);
  const size_t hb = ((size_t)(layer * NSEQ + seq) * 4 + head) * 256 * 64;
  f32x16 O[2];
  float lsum;
  attn_core<64>(qf, (const short*)(p.ws + OFF_KMEM) + hb, (const short*)(p.ws + OFF_VMEM) + hb, 256, 2, smem, O, lsum);
  attn_store(O, lsum, tok, 768 + head * 64, (const short*)(p.ws + OFF_GATE), (short*)(p.ws + OFF_O), smem);
}

DI void sgu_item(PRef p, int jb, int pair, char* smem) {
  constexpr int WROW = 272;
  const int tid_ = my_tid(), hb_ = tid_ >> 8;
  const int tid = tid_ & 255, lane = tid & 63, w = tid >> 6, r = lane & 31, h = lane >> 5;
  const int item = pair * 2 + hb_, chunk = item >> 3, g = item & 7;
  smem += hb_ * 60928;
  char* sw = smem;
  char* sv = smem + 128 * WROW;
  const int tok0 = chunk * 128;
  u32x4 upre[6], gpre[6];
#pragma unroll
  for (int i = 0; i < 6; i++) {
    const int idx = tid + 256 * i, row = idx / 12, ch = idx - row * 12;
    upre[i] = *(const u32x4*)((const short*)(p.ws + OFF_U) + (size_t)(tok0 + row) * 768 + g * 96 + ch * 8);
    gpre[i] = *(const u32x4*)((const short*)(p.ws + OFF_GATE) + (size_t)(tok0 + row) * 1024 + g * 96 + ch * 8);
  }
  const short* Ws = (const short*)(p.ws + OFF_WS) + (size_t)(jb * 8 + g) * 128 * 128;
  const short* VT = (const short*)(p.ws + OFF_K);
  const float* ssqv = (const float*)(p.ws + OFF_SSQ) + (size_t)(8 + jb) * T;
  const float* vg = p.in[13] + jb * 768 + g * 96;
#pragma unroll
  for (int i = 0; i < 8; i++) {
    int c = tid + 256 * i, row = c >> 4, col = c & 15;
    *(u32x4*)(sw + row * WROW + col * 16) = *(const u32x4*)(Ws + row * 128 + col * 8);
  }
#pragma unroll
  for (int i = 0; i < 6; i++) {
    int c = tid + 256 * i, row = c >> 4, col = c & 15;
    u32x4 t = *(const u32x4*)(VT + (size_t)(g * 96 + row) * T + tok0 + col * 8);
    const float gg = vg[row];
    const float* sq = ssqv + tok0 + col * 8;
    u32x4 o;
#pragma unroll
    for (int e = 0; e < 4; e++) {
      float r0 = rsqrt_f(sq[2 * e] * (1.f / 768.f) + EPS), r1 = rsqrt_f(sq[2 * e + 1] * (1.f / 768.f) + EPS);
      o[e] = pack_bf16(bf_lo(t[e]) * r0 * gg, bf_hi(t[e]) * r1 * gg);
    }
    *(u32x4*)(sv + row * WROW + col * 16) = o;
  }
  __syncthreads();
  f32x16 acc[3];
#pragma unroll
  for (int n = 0; n < 3; n++)
#pragma unroll
    for (int i = 0; i < 16; i++) acc[n][i] = 0.f;
  const char* ap = sw + (w * 32 + r) * WROW + h * 16;
  const char* bp = sv + r * WROW + h * 16;
#pragma unroll
  for (int ks = 0; ks < 8; ks++) {
    bf16x8 a = *(const bf16x8*)(ap + ks * 32);
#pragma unroll
    for (int n = 0; n < 3; n++) {
      bf16x8 b = *(const bf16x8*)(bp + n * 32 * WROW + ks * 32);
      acc[n] = MFMA(a, b, acc[n]);
    }
  }
  __syncthreads();
  float* sf = (float*)smem;
#pragma unroll
  for (int n = 0; n < 3; n++)
#pragma unroll
    for (int i = 0; i < 16; i++) {
      int row = w * 32 + (i & 3) + 8 * (i >> 2) + 4 * h;
      sf[row * 100 + n * 32 + r] = acc[n][i];
    }
  __syncthreads();
  {
#pragma unroll
    for (int i = 0; i < 6; i++) {
      const int idx = tid + 256 * i, row = idx / 12, ch = idx - row * 12;
      const int tok = tok0 + row;
      const float bias = p.in[15][(size_t)(jb * 8 + g) * 128 + row];
      const u32x4 uu = upre[i], gg = gpre[i];
      const float* mp = sf + row * 100 + ch * 8;
      const f32x4 m0 = *(const f32x4*)mp, m1 = *(const f32x4*)(mp + 4);
      u32x4 o;
      o[0] = pack_bf16((m0[0] + bias) * bf_lo(uu[0]) * bf_lo(gg[0]), (m0[1] + bias) * bf_hi(uu[0]) * bf_hi(gg[0]));
      o[1] = pack_bf16((m0[2] + bias) * bf_lo(uu[1]) * bf_lo(gg[1]), (m0[3] + bias) * bf_hi(uu[1]) * bf_hi(gg[1]));
      o[2] = pack_bf16((m1[0] + bias) * bf_lo(uu[2]) * bf_lo(gg[2]), (m1[1] + bias) * bf_hi(uu[2]) * bf_hi(gg[2]));
      o[3] = pack_bf16((m1[2] + bias) * bf_lo(uu[3]) * bf_lo(gg[3]), (m1[3] + bias) * bf_hi(uu[3]) * bf_hi(gg[3]));
      __builtin_nontemporal_store(o, (u32x4*)((short*)(p.ws + OFF_O) + (size_t)tok * 1024 + g * 96 + ch * 8));
    }
  }
  __syncthreads();
}

DI void conv_w(const float* W, int K, int Nsrc, int Ndst, const float* g, short* dst, int remap, int gtid, int gthreads) {
  asm volatile("" : "+s"(gthreads));
  const int kgs = K >> 3;
  const int total = Ndst * kgs;
  for (int idx = gtid; idx < total; idx += gthreads) {
    int n = idx % Ndst, kg = idx / Ndst;
    int src = n;
    if (remap) src = n < 640 ? n : (n < 1920 ? n + 32 : (n < 1952 ? n - 1280 : -1));
    float v[8];
#pragma unroll
    for (int e = 0; e < 8; e++) {
      int k = kg * 8 + e;
      float x = src >= 0 ? W[(size_t)k * Nsrc + src] : 0.f;
      if (g) x *= g[k];
      v[e] = x;
    }
    u32x4 o;
#pragma unroll
    for (int e = 0; e < 4; e++) o[e] = pack_bf16(v[2 * e], v[2 * e + 1]);
    *(u32x4*)(dst + (size_t)n * K + kg * 8) = o;
  }
}

DI void phase_prep(PRef p) {
  const int tid0 = my_tid();
  const int gtid = blockIdx.x * 512 + tid0, gthreads = gridDim.x * 512;
  char* ws = p.ws;
  for (int j = 0; j < 2; j++) {
    conv_w(p.in[5] + (size_t)j * 1024 * 1952, 1024, 1952, 2048, p.in[4] + (2 * j) * 1024, (short*)(ws + OFF_WIA) + (size_t)j * 2048 * 1024, 1, gtid, gthreads);
    conv_w(p.in[12] + (size_t)j * 1024 * 2816, 1024, 2816, 2816, p.in[4] + (2 * j + 1) * 1024, (short*)(ws + OFF_WIB) + (size_t)j * 2816 * 1024, 0, gtid, gthreads);
    conv_w(p.in[8] + (size_t)j * 384 * 1152, 384, 1152, 1152, p.in[6] + j * 384, (short*)(ws + OFF_WUQ) + (size_t)j * 1152 * 384, 0, gtid, gthreads);
    conv_w(p.in[9] + (size_t)j * 256 * 1536, 256, 1536, 1536, p.in[7] + j * 256, (short*)(ws + OFF_WUKV) + (size_t)j * 1536 * 256, 0, gtid, gthreads);
  }
  for (int i = 0; i < 4; i++) {
    conv_w(p.in[17] + (size_t)i * 1024 * 512, 1024, 512, 512, p.in[16] + i * 1024, (short*)(ws + OFF_WMKV) + (size_t)i * 512 * 1024, 0, gtid, gthreads);
    conv_w(p.in[20] + (size_t)i * 1024 * 1024, 1024, 1024, 1024, nullptr, (short*)(ws + OFF_WOUT) + (size_t)i * 1024 * 1024, 0, gtid, gthreads);
  }
  {
    const float* src = p.in[14];
    unsigned* dst = (unsigned*)(ws + OFF_WS);
    for (int idx = gtid; idx < 2 * 8 * 128 * 128 / 2; idx += gthreads) dst[idx] = pack_bf16(src[2 * idx], src[2 * idx + 1]);
  }
  {
    float* z = (float*)(ws + OFF_SSQ) + T;
    for (int idx = gtid; idx < 9 * T; idx += gthreads) z[idx] = 0.f;
  }
  {
    const int gw = gtid >> 6, nw = gthreads >> 6, lane = tid0 & 63;
    float* ssqx = (float*)(ws + OFF_SSQ);
    float* ssqm = (float*)(ws + OFF_SSQM);
    for (int row = gw; row < T + MEMROWS; row += nw) {
      const float* src;
      short* dstb;
      if (row < TP) src = p.in[0] + (size_t)row * 1024;
      else if (row < T) src = p.in[1] + (size_t)(row - TP) * 1024;
      else if (row < T + 256) src = p.in[2] + (size_t)(row - T) * 1024;
      else src = p.in[3] + (size_t)(row - T - 256) * 1024;
      if (row < T) dstb = (short*)(ws + OFF_XB) + (size_t)row * 1024;
      else dstb = (short*)(ws + OFF_MEMB) + (size_t)(row - T) * 1024;
      float ss = 0.f;
#pragma unroll
      for (int c = 0; c < 2; c++) {
        f32x4 v0 = *(const f32x4*)(src + c * 512 + lane * 8);
        f32x4 v1 = *(const f32x4*)(src + c * 512 + lane * 8 + 4);
        ss += v0[0] * v0[0] + v0[1] * v0[1] + v0[2] * v0[2] + v0[3] * v0[3] + v1[0] * v1[0] + v1[1] * v1[1] + v1[2] * v1[2] + v1[3] * v1[3];
        u32x4 o;
        o[0] = pack_bf16(v0[0], v0[1]); o[1] = pack_bf16(v0[2], v0[3]); o[2] = pack_bf16(v1[0], v1[1]); o[3] = pack_bf16(v1[2], v1[3]);
        *(u32x4*)(dstb + c * 512 + lane * 8) = o;
      }
#pragma unroll
      for (int o = 32; o >= 1; o >>= 1) ss += __shfl_xor(ss, o);
      if (lane == 0) {
        if (row < T) ssqx[row] = ss; else ssqm[row - T] = ss;
      }
    }
  }
}

DI void prefetch_ssq(u32x4 (&pre)[8], const float* ssq, int m0) {
  const int t_ = my_tid() & 255, ln_ = t_ & 63, ww_ = t_ >> 6;
#pragma unroll
  for (int s_ = 0; s_ < 8; s_++) pre[s_] = u32x4{__float_as_uint(ssq[m0 + ww_ * 32 + s_ * 4 + (ln_ >> 4)]), 0u, 0u, 0u};
}

DI short* xb_ptr(PRef p, int layer) { return (layer == 1 || layer == 2) ? (short*)p.out : (short*)(p.ws + OFF_XB); }
DI const float* x_rows(PRef p, int layer, int m0) {
  if (layer == 0) return m0 < TP ? p.in[0] + (size_t)m0 * 1024 : p.in[1] + (size_t)(m0 - TP) * 1024;
  return p.out + (size_t)m0 * 1024;
}

DI void memkv_tile(PRef p, int it, char* smem) {
  const int layer = it / 34, rem = it % 34, mt = rem >> 1, nt2 = rem & 1;
  const short* A = (const short*)(p.ws + OFF_MEMB) + (size_t)mt * 256 * 1024;
  const short* B = (const short*)(p.ws + OFF_WMKV) + ((size_t)layer * 512 + nt2 * 256) * 1024;
  f32x16 acc[4][2];
  gemm_main<false>(A, 1024, B, 1024, smem, acc);
  const int nt = nt2 * 2 + (my_tid() >> 8);
#pragma unroll
  for (int pm = 0; pm < 2; pm++) {
    u32x4 pre[8];
    prefetch_ssq(pre, (const float*)(p.ws + OFF_SSQM), mt * 256 + pm * 128);
    stage_half(acc, pm, smem);
    const int m0 = mt * 256 + pm * 128;
    Epi e{};
    e.m0 = m0;
    e.ssq_in = (const float*)(p.ws + OFF_SSQM);
    e.inv_k = 1.f / 1024.f;
    const int seq = m0 >> 8, key0 = m0 & 255;
    const int head0 = (nt & 1) * 2;
    const size_t hb = ((size_t)(layer * NSEQ + seq) * 4 + head0) * 256 * 64;
    if (nt < 2) {
      e.type = EPI_MEMK;
      e.g = p.in[19] + layer * 64;
      e.dst = (short*)(p.ws + OFF_KMEM) + hb + (size_t)key0 * 64;
    } else {
      e.type = EPI_MEMV;
      e.dst = (short*)(p.ws + OFF_VMEM) + hb + key0;
    }
    gemm_epilogue(e, smem, pre, true);
  }
}

DI void inproj_a_tile(PRef p, int layer, int mt, int nt2, char* smem, int noatom) {
  const int j = layer >> 1;
  const short* B = (const short*)(p.ws + OFF_WIA) + ((size_t)j * 2048 + nt2 * 256) * 1024;
  f32x16 acc[4][2];
  gemm_main<false>(xb_ptr(p, layer) + (size_t)mt * 256 * 1024, 1024, B, 1024, smem, acc);
  const int nt = nt2 * 2 + (my_tid() >> 8);
#pragma unroll
  for (int pm = 0; pm < 2; pm++) {
    u32x4 pre[8];
    prefetch_ssq(pre, (const float*)(p.ws + OFF_SSQ) + (size_t)layer * T, mt * 256 + pm * 128);
    stage_half(acc, pm, smem);
    Epi e{};
    e.m0 = mt * 256 + pm * 128;
    e.ssq_in = (const float*)(p.ws + OFF_SSQ) + (size_t)layer * T;
    e.inv_k = 1.f / 1024.f;
    if (nt < 3) {
      e.type = EPI_BF16_SSQ; e.dst = (short*)(p.ws + OFF_QLAT); e.ld = 384; e.col0 = nt * 128;
      e.ssq_out = (float*)(p.ws + OFF_SSQ) + (size_t)(4 + j) * T;
    } else if (nt < 5) {
      e.type = EPI_BF16_SSQ; e.dst = (short*)(p.ws + OFF_KVLAT); e.ld = 256; e.col0 = (nt - 3) * 128;
      e.ssq_out = (float*)(p.ws + OFF_SSQ) + (size_t)(6 + j) * T;
    } else if (nt < 7) {
      e.type = EPI_QMEM; e.dst = (short*)(p.ws + OFF_QMEM); e.ld = 256; e.col0 = (nt - 5) * 128; e.g = p.in[18] + layer * 64;
    } else if (nt < 15) {
      e.type = EPI_GATE; e.dst = (short*)(p.ws + OFF_GATE); e.ld = 1024; e.col0 = (nt - 7) * 128;
    } else {
      e.type = EPI_KPE; e.fdst = (float*)(p.ws + OFF_KPE);
    }
    if (noatom) e.ssq_out = nullptr;
    gemm_epilogue(e, smem, pre, true);
  }
}

DI void inproj_b_tile(PRef p, int layer, int mt, int nt2, char* smem, int noatom) {
  const int j = layer >> 1;
  const short* B = (const short*)(p.ws + OFF_WIB) + ((size_t)j * 2816 + nt2 * 256) * 1024;
  f32x16 acc[4][2];
  gemm_main<false>(xb_ptr(p, layer) + (size_t)mt * 256 * 1024, 1024, B, 1024, smem, acc);
  const int nt = nt2 * 2 + (my_tid() >> 8);
#pragma unroll
  for (int pm = 0; pm < 2; pm++) {
    u32x4 pre[8];
    prefetch_ssq(pre, (const float*)(p.ws + OFF_SSQ) + (size_t)layer * T, mt * 256 + pm * 128);
    stage_half(acc, pm, smem);
    Epi e{};
    e.m0 = mt * 256 + pm * 128;
    e.ssq_in = (const float*)(p.ws + OFF_SSQ) + (size_t)layer * T;
    e.inv_k = 1.f / 1024.f;
    if (nt < 6) {
      e.type = EPI_U; e.dst = (short*)(p.ws + OFF_U); e.ld = 768; e.col0 = nt * 128;
    } else if (nt < 12) {
      e.type = EPI_VT; e.dst = (short*)(p.ws + OFF_K); e.col0 = (nt - 6) * 128;
      e.ssq_out = (float*)(p.ws + OFF_SSQ) + (size_t)(8 + j) * T;
    } else if (nt < 14) {
      e.type = EPI_QMEM; e.dst = (short*)(p.ws + OFF_QMEM); e.ld = 256; e.col0 = (nt - 12) * 128; e.g = p.in[18] + layer * 64;
    } else {
      e.type = EPI_GATE; e.dst = (short*)(p.ws + OFF_GATE); e.ld = 1024; e.col0 = (nt - 14) * 128;
    }
    if (noatom) e.ssq_out = nullptr;
    gemm_epilogue(e, smem, pre, true);
  }
}

DI void upproj_tile(PRef p, int layer, int mt, int nt2, char* smem) {
  const int j = layer >> 1;
  f32x16 acc[4][2];
  if (nt2 < 5) {
    const short* A = (const short*)(p.ws + OFF_QLAT) + (size_t)mt * 256 * 384;
    const short* B = (const short*)(p.ws + OFF_WUQ) + ((size_t)j * 1152 + nt2 * 256) * 384;
    gemm_main<false>(A, 384, B, 384, smem, acc);
  } else {
    const short* A = (const short*)(p.ws + OFF_KVLAT) + (size_t)mt * 256 * 256;
    const short* B = (const short*)(p.ws + OFF_WUKV) + ((size_t)j * 1536 + (nt2 - 5) * 256) * 256;
    gemm_main<false>(A, 256, B, 256, smem, acc);
  }
  const int hbk = my_tid() >> 8;
#pragma unroll
  for (int pm = 0; pm < 2; pm++) {
    u32x4 pre[8];
    prefetch_ssq(pre, (const float*)(p.ws + OFF_SSQ) + (size_t)((nt2 < 5 ? 4 : 6) + j) * T, mt * 256 + pm * 128);
    stage_half(acc, pm, smem);
    Epi e{};
    e.m0 = mt * 256 + pm * 128;
    if (nt2 < 5) {
      const int nt = nt2 * 2 + hbk;
      e.type = nt < 9 ? EPI_BF16 : EPI_NONE; e.dst = (short*)(p.ws + OFF_Q); e.ld = 1152; e.col0 = nt * 128;
      e.ssq_in = (const float*)(p.ws + OFF_SSQ) + (size_t)(4 + j) * T;
      e.inv_k = 1.f / 384.f;
    } else {
      e.type = EPI_KV;
      e.ssq_in = (const float*)(p.ws + OFF_SSQ) + (size_t)(6 + j) * T;
      e.inv_k = 1.f / 256.f;
      e.kpe = (const float*)(p.ws + OFF_KPE);
      e.g = p.in[11] + j * 96;
      e.kdst = (short*)(p.ws + OFF_K);
      e.vtdst = (short*)(p.ws + OFF_VT);
      e.head = (nt2 - 5) * 2 + hbk;
    }
    gemm_epilogue(e, smem, pre, true);
  }
}

DI void outproj_tile(PRef p, int layer, int mt, int nt2, char* smem, int noatom) {
  const short* A = (const short*)(p.ws + OFF_O) + (size_t)mt * 256 * 1024;
  const short* B = (const short*)(p.ws + OFF_WOUT) + ((size_t)layer * 1024 + nt2 * 256) * 1024;
  f32x16 acc[4][2];
  gemm_main<false>(A, 1024, B, 1024, smem, acc);
  const int nt = nt2 * 2 + (my_tid() >> 8);
#pragma unroll
  for (int pm = 0; pm < 2; pm++) {
    u32x4 pre[8];
#pragma unroll
    for (int s_ = 0; s_ < 8; s_++) pre[s_] = u32x4{0u, 0u, 0u, 0u};
    if (layer > 0) {
      const short* xb = xb_ptr(p, layer);
      const int t_ = my_tid() & 255, ln_ = t_ & 63, ww_ = t_ >> 6;
#pragma unroll
      for (int s_ = 0; s_ < 8; s_++) {
        const int row_ = ww_ * 32 + s_ * 4 + (ln_ >> 4);
        pre[s_] = *(const u32x4*)(xb + (size_t)(mt * 256 + pm * 128 + row_) * 1024 + nt * 128 + (ln_ & 15) * 8);
      }
    }
    stage_half(acc, pm, smem);
    Epi e{};
    e.type = EPI_OUT;
    e.m0 = mt * 256 + pm * 128;
    e.col0 = nt * 128;
    e.xold = layer == 0 ? x_rows(p, 0, e.m0) : nullptr;
    e.xoldb = layer == 0 ? nullptr : xb_ptr(p, layer);
    e.xnew = layer == 3 ? p.out : nullptr;
    e.dst = layer < 3 ? xb_ptr(p, layer + 1) : nullptr;
    e.ssq_out = (layer < 3 && !noatom) ? (float*)(p.ws + OFF_SSQ) + (size_t)(layer + 1) * T : nullptr;
    gemm_epilogue(e, smem, pre, layer > 0);
  }
}

DI bool gemm_tile_at(int k, int NT, int G, int& mt, int& nt) {
  const int xcd = blockIdx.x & 7, l = blockIdx.x >> 3, nl = gridDim.x >> 3;
  const int li = l + k * nl;
  if (li >= 40 * NT) return false;
  const int ng = li / (40 * G);
  const int rem = li - ng * 40 * G;
  const int gsz = min(G, NT - ng * G);
  const int lm = rem / gsz;
  mt = lm * 8 + xcd;
  nt = ng * G + (rem - lm * gsz);
  return true;
}

constexpr int NPHASE = 15;

DI void run_phase(PRef p, int ph, char* smem, int noatom) {
  const int nb = gridDim.x, b = blockIdx.x;
  if (ph == 0) { phase_prep(p); return; }
  if (ph == 1) {
    for (int it = b; it < 136; it += nb) memkv_tile(p, it, smem);
    { int mt, nt; for (int k = 0; gemm_tile_at(k, 8, 4, mt, nt); k++) inproj_a_tile(p, 0, mt, nt, smem, noatom); }
    return;
  }
  int layer, sub;
  if (ph <= 4) { layer = 0; sub = ph - 1; }
  else if (ph <= 7) { layer = 1; sub = ph == 5 ? 0 : ph - 4; }
  else if (ph <= 11) { layer = 2; sub = ph - 8; }
  else { layer = 3; sub = ph == 12 ? 0 : ph - 11; }
  const int j = layer >> 1;
  const bool isA = (layer & 1) == 0;
  if (sub == 0) {
    int mt, nt;
    if (isA) for (int k = 0; gemm_tile_at(k, 8, 4, mt, nt); k++) inproj_a_tile(p, layer, mt, nt, smem, noatom);
    else for (int k = 0; gemm_tile_at(k, 11, 4, mt, nt); k++) inproj_b_tile(p, layer, mt, nt, smem, noatom);
  } else if (sub == 1) {
    int mt, nt;
    for (int k = 0; gemm_tile_at(k, 11, 11, mt, nt); k++) upproj_tile(p, layer, mt, nt, smem);
  } else if (sub == 2) {
    if (isA) {
      if ((nb & 7) == 0) {
        const int xj = b & 7, l = b >> 3, nl = nb >> 3;
        for (int li = l; li < 96; li += nl) {
          const int u = xj + 8 * (li >> 5);
          mla_item(p, j, 0, u >> 1, (u & 1) * 32 + (li & 31), smem);
        }
        for (int li = l; li < 384; li += nl) {
          const int u = xj + 8 * (li >> 4);
          mla_item(p, j, 1 + u / 12, u % 12, li & 15, smem);
        }
      } else {
        for (int it = b; it < 768 + 3072; it += nb) {
          if (it < 768) mla_item(p, j, 0, it >> 6, it & 63, smem);
          else { int u = it - 768; int bh = u >> 4; mla_item(p, j, 1 + bh / 12, bh % 12, u & 15, smem); }
        }
      }
      for (int it = b; it < 1280; it += nb) memattn_item(p, layer, it >> 2, it & 3, smem);
    } else {
      for (int it = b; it < 2560 + 1280; it += nb) {
        if (it < 2560) sgu_item(p, j, it, smem);
        else { int u = it - 2560; memattn_item(p, layer, u >> 2, u & 3, smem); }
      }
    }
  } else {
    int mt, nt;
    for (int k = 0; gemm_tile_at(k, 4, 4, mt, nt); k++) outproj_tile(p, layer, mt, nt, smem, noatom);
  }
}

__global__ void __launch_bounds__(512, 2) mega(Params p_, int ph_lo, int ph_hi, int coop) {
  __shared__ __attribute__((aligned(16))) char smem[SMEM_BYTES];
  PRef p = *(const __attribute__((address_space(4))) Params*)__builtin_amdgcn_kernarg_segment_ptr();
  for (int ph = ph_lo; ph < ph_hi; ph++) {
    run_phase(p, ph, smem, 0);
    if (coop && ph + 1 < ph_hi) cg::this_grid().sync();
#if DUPMASK
    if ((DUPMASK >> ph) & 1) { run_phase(p, ph, smem, 1); cg::this_grid().sync(); }
#endif
  }
}

#ifndef MULTI_LAUNCH
#define MULTI_LAUNCH 0
#endif

extern "C" void kernel_launch(void* const* d_in, const int* in_sizes, int n_in, void* d_out, int out_size, void* d_ws,
                              size_t ws_size, hipStream_t stream) {
  static int grid_blocks = 0;
  if (!grid_blocks) {
    int dev = 0, cus = 0, per_cu = 0;
    hipGetDevice(&dev);
    hipDeviceGetAttribute(&cus, hipDeviceAttributeMultiprocessorCount, dev);
    hipOccupancyMaxActiveBlocksPerMultiprocessor(&per_cu, mega, 512, 0);
    if (per_cu > 1) per_cu = 1;
    if (per_cu < 1) per_cu = 1;
    grid_blocks = (cus * per_cu) & ~7;
  }
  Params p{};
  for (int i = 0; i < 21; i++) p.in[i] = (const float*)d_in[i];
  p.out = (float*)d_out;
  p.ws = (char*)d_ws;
  if (ws_size < WS_TOTAL) { fprintf(stderr, "workspace too small: %zu < %zu\n", ws_size, (size_t)WS_TOTAL); }
#if MULTI_LAUNCH
  for (int ph = 0; ph < NPHASE; ph++) {
    hipLaunchKernelGGL(mega, dim3(grid_blocks), dim3(512), 0, stream, p, ph, ph + 1, 0);
  }
#else
  int lo = 0, hi = NPHASE, coop = 1;
  void* args[] = {&p, &lo, &hi, &coop};
  hipError_t e = hipLaunchCooperativeKernel((void*)mega, dim3(grid_blocks), dim3(512), args, 0, stream);
  if (e != hipSuccess) fprintf(stderr, "cooperative launch failed: %s (grid %d)\n", hipGetErrorString(e), grid_blocks);
#endif
}
```

```cpp
#include <hip/hip_runtime.h>
#include <hip/hip_cooperative_groups.h>
#include <cstdio>
namespace cg = cooperative_groups;
#define DUPMASK 0

typedef __attribute__((ext_vector_type(8))) short bf16x8;
typedef __attribute__((ext_vector_type(16))) float f32x16;
typedef __attribute__((ext_vector_type(4))) float f32x4;
typedef __attribute__((ext_vector_type(4))) unsigned u32x4;
typedef __attribute__((ext_vector_type(2))) unsigned u32x2;
typedef __attribute__((ext_vector_type(2))) float f32x2;
typedef __attribute__((ext_vector_type(2))) __bf16 bf16x2_t;

#define DI __device__ __forceinline__
#define MFMA(a, b, c) __builtin_amdgcn_mfma_f32_32x32x16_bf16((a), (b), (c), 0, 0, 0)

constexpr int T = 81920;
constexpr int TP = 16384;
constexpr int SS = 4096;
constexpr int NSEQ = 17;
constexpr int MEMROWS = NSEQ * 256;
constexpr float EPS = 1e-6f;
constexpr float LOG2E = 1.4426950408889634f;

constexpr size_t SZ_WIA = (size_t)2 * 2048 * 1024 * 2;
constexpr size_t SZ_WIB = (size_t)2 * 2816 * 1024 * 2;
constexpr size_t SZ_WUQ = (size_t)2 * 1152 * 384 * 2;
constexpr size_t SZ_WUKV = (size_t)2 * 1536 * 256 * 2;
constexpr size_t SZ_WMKV = (size_t)4 * 512 * 1024 * 2;
constexpr size_t SZ_WOUT = (size_t)4 * 1024 * 1024 * 2;
constexpr size_t SZ_WS = (size_t)2 * 8 * 128 * 128 * 2;
constexpr size_t OFF_WIA = 0;
constexpr size_t OFF_WIB = OFF_WIA + SZ_WIA;
constexpr size_t OFF_WUQ = OFF_WIB + SZ_WIB;
constexpr size_t OFF_WUKV = OFF_WUQ + SZ_WUQ;
constexpr size_t OFF_WMKV = OFF_WUKV + SZ_WUKV;
constexpr size_t OFF_WOUT = OFF_WMKV + SZ_WMKV;
constexpr size_t OFF_WS = OFF_WOUT + SZ_WOUT;
constexpr size_t OFF_SSQ = OFF_WS + SZ_WS;
constexpr size_t OFF_SSQM = OFF_SSQ + (size_t)10 * T * 4;
constexpr size_t OFF_KMEM = OFF_SSQM + 32768;
constexpr size_t SZ_KMEM = (size_t)4 * MEMROWS * 256 * 2;
constexpr size_t OFF_VMEM = OFF_KMEM + SZ_KMEM;
constexpr size_t OFF_MEMB = OFF_VMEM + SZ_KMEM;
constexpr size_t OFF_O = OFF_MEMB + (size_t)MEMROWS * 1024 * 2;
constexpr size_t OFF_QLAT = OFF_O;
constexpr size_t OFF_KVLAT = OFF_QLAT + (size_t)T * 384 * 2;
constexpr size_t OFF_KPE = OFF_KVLAT + (size_t)T * 256 * 2;
constexpr size_t OFF_Q = OFF_O + (size_t)T * 1024 * 2;
constexpr size_t OFF_XB = OFF_Q;
constexpr size_t OFF_K = OFF_Q + (size_t)T * 1152 * 2;
constexpr size_t OFF_VT = OFF_K + (size_t)T * 1152 * 2;
constexpr size_t OFF_U = OFF_VT;
constexpr size_t OFF_QMEM = OFF_VT + (size_t)T * 768 * 2;
constexpr size_t OFF_GATE = OFF_QMEM + (size_t)T * 256 * 2;
constexpr size_t WS_TOTAL = OFF_GATE + (size_t)T * 1024 * 2;

struct Params {
  const float* in[21];
  float* out;
  char* ws;
};

typedef const __attribute__((address_space(4))) Params& PRef;

DI unsigned pack_bf16(float a, float b) {
  f32x2 v = {a, b};
  bf16x2_t r = __builtin_convertvector(v, bf16x2_t);
  return __builtin_bit_cast(unsigned, r);
}
DI int my_tid() { int t = threadIdx.x; asm volatile("" : "+v"(t)); return t; }
DI float bf_lo(unsigned u) { return __uint_as_float(u << 16); }
DI float bf_hi(unsigned u) { return __uint_as_float(u & 0xffff0000u); }
DI float rsqrt_f(float x) { return __builtin_amdgcn_rsqf(x); }
DI float exp2_f(float x) { return __builtin_amdgcn_exp2f(x); }
DI float silu_f(float x) { return x * __builtin_amdgcn_rcpf(1.f + exp2_f(-x * LOG2E)); }
DI float gelu_f(float x) {
  float u = 0.7978845608028654f * (x + 0.044715f * x * x * x);
  return x * __builtin_amdgcn_rcpf(1.f + exp2_f(-2.f * LOG2E * u));
}
DI void atomic_add_f(float* p, float v) { __hip_atomic_fetch_add(p, v, __ATOMIC_RELAXED, __HIP_MEMORY_SCOPE_AGENT); }

__device__ const double ROPE_TURNS[16] = {
  0.15915494309189535, 0.08949887106850354, 0.05032921210448704, 0.028302194144593214,
  0.015915494309189534, 0.008949887106850355, 0.005032921210448704, 0.0028302194144593215,
  0.0015915494309189536, 0.0008949887106850354, 0.0005032921210448704, 0.00028302194144593214,
  0.00015915494309189535, 8.949887106850354e-05, 5.032921210448704e-05, 2.8302194144593215e-05};
DI void rope_cs(int pos, int i, float& c, float& s) {
  double t = (double)pos * ROPE_TURNS[i];
  t -= floor(t);
  float fr = (float)t;
  s = __builtin_amdgcn_sinf(fr);
  c = __builtin_amdgcn_cosf(fr);
}
DI int tok_pos(int tok) { return tok < TP ? tok : ((tok - TP) & (SS - 1)); }
DI int tok_seq(int tok) { return tok < TP ? 0 : 1 + ((tok - TP) >> 12); }

constexpr int LROW = 144;
constexpr int STAGE_BYTES = 2 * 128 * LROW;
constexpr int SF_BYTES = 128 * 132 * 4;
constexpr int SMEM_BYTES = 2 * SF_BYTES;
constexpr int SF_LD = 132;

#define RAW_BARRIER() do { asm volatile("s_waitcnt lgkmcnt(0)" ::: "memory"); __builtin_amdgcn_s_barrier(); } while (0)
#define WAIT_VM(n) asm volatile("s_waitcnt vmcnt(" #n ")" ::: "memory")

constexpr int GBK = 32;
constexpr int GSTAGE = 32768;
constexpr int GBOFF = 16384;
template <bool AF32>
DI void gemm_main(const void* Ap, int lda, const short* Bp, int K, char* smem, f32x16 (&acc)[4][2]) {
  const int tid = my_tid(), lane = tid & 63, w = tid >> 6, r = lane & 31, h = lane >> 5;
  const int wm = w >> 2, wn = w & 3;
#pragma unroll
  for (int a = 0; a < 4; a++)
#pragma unroll
    for (int b = 0; b < 2; b++)
#pragma unroll
      for (int i = 0; i < 16; i++) acc[a][b][i] = 0.f;

  const int lch = (lane & 3) ^ ((lane >> 4) & 3);
  const short* ga = (const short*)Ap + (size_t)(w * 32 + (lane >> 2)) * lda + lch * 8;
  const short* gb = Bp + (size_t)(w * 32 + (lane >> 2)) * K + lch * 8;
  const size_t a16 = (size_t)16 * lda, b16 = (size_t)16 * K;
  char* lbase = smem + w * 2048;
#define GLDS(kt, slot)                                                                                                     \
  {                                                                                                                        \
    char* l_ = lbase + (slot) * GSTAGE;                                                                                    \
    __builtin_amdgcn_global_load_lds((const unsigned*)(ga + (kt) * GBK), (unsigned*)(l_), 16, 0, 0);                       \
    __builtin_amdgcn_global_load_lds((const unsigned*)(ga + a16 + (kt) * GBK), (unsigned*)(l_ + 1024), 16, 0, 0);          \
    __builtin_amdgcn_global_load_lds((const unsigned*)(gb + (kt) * GBK), (unsigned*)(l_ + GBOFF), 16, 0, 0);               \
    __builtin_amdgcn_global_load_lds((const unsigned*)(gb + b16 + (kt) * GBK), (unsigned*)(l_ + GBOFF + 1024), 16, 0, 0);  \
  }
  const int x = (r >> 2) & 3;
  const int off0 = ((h ^ x) << 4);
  const int aoff = (wm * 128 + r) * 64, boff = GBOFF + (wn * 64 + r) * 64;
  struct Frag { bf16x8 a[4], b0, b1; };
#define LOADF(F, slot, ks)                                                                  \
  {                                                                                         \
    const char* sa_ = smem + (slot) * GSTAGE + aoff + (off0 ^ ((ks) << 5));                 \
    const char* sb_ = smem + (slot) * GSTAGE + boff + (off0 ^ ((ks) << 5));                 \
    F.b0 = *(const bf16x8*)(sb_);                                                           \
    F.b1 = *(const bf16x8*)(sb_ + 2048);                                                    \
    _Pragma("unroll") for (int mi = 0; mi < 4; mi++) F.a[mi] = *(const bf16x8*)(sa_ + mi * 2048); \
  }
#define MM(F)                                                                               \
  {                                                                                         \
    _Pragma("unroll") for (int mi = 0; mi < 4; mi++) {                                      \
      acc[mi][0] = MFMA(F.a[mi], F.b0, acc[mi][0]);                                         \
      acc[mi][1] = MFMA(F.a[mi], F.b1, acc[mi][1]);                                         \
    }                                                                                       \
  }
  const int nk = K >> 5;
  Frag F0, F1;
  GLDS(0, 0);
  GLDS(1, 1);
  GLDS(2, 2);
  GLDS(3, 3);
  WAIT_VM(12);
  RAW_BARRIER();
  LOADF(F0, 0, 0);
  for (int kt = 0; kt < nk - 3; kt++) {
    LOADF(F1, kt & 3, 1);
    MM(F0);
    WAIT_VM(8);
    RAW_BARRIER();
    if (kt + 4 < nk) GLDS(kt + 4, kt & 3);
    LOADF(F0, (kt + 1) & 3, 0);
    MM(F1);
  }
  LOADF(F1, (nk - 3) & 3, 1);
  MM(F0);
  WAIT_VM(4);
  RAW_BARRIER();
  LOADF(F0, (nk - 2) & 3, 0);
  MM(F1);
  LOADF(F1, (nk - 2) & 3, 1);
  MM(F0);
  WAIT_VM(0);
  RAW_BARRIER();
  LOADF(F0, (nk - 1) & 3, 0);
  MM(F1);
  LOADF(F1, (nk - 1) & 3, 1);
  MM(F0);
  MM(F1);
  __syncthreads();
#undef LOADF
#undef MM
#undef GLDS
}

DI void stage_half(const f32x16 (&acc)[4][2], int pm, char* smem) {
  const int tid = my_tid(), lane = tid & 63, w = tid >> 6, r = lane & 31, h = lane >> 5;
  const int wm = w >> 2, wn = w & 3;
  float* sf = (float*)(smem + (wn >> 1) * SF_BYTES);
  if (wm == pm) {
#pragma unroll
    for (int mi = 0; mi < 4; mi++)
#pragma unroll
      for (int ni = 0; ni < 2; ni++)
#pragma unroll
        for (int i = 0; i < 16; i++) {
          int row = mi * 32 + (i & 3) + 8 * (i >> 2) + 4 * h;
          int col = (wn & 1) * 64 + ni * 32 + r;
          sf[row * SF_LD + col] = acc[mi][ni][i];
        }
  }
  __syncthreads();
}

enum { EPI_BF16 = 0, EPI_BF16_SSQ, EPI_QMEM, EPI_GATE, EPI_KPE, EPI_KV, EPI_OUT, EPI_U, EPI_VT, EPI_MEMK, EPI_MEMV, EPI_NONE };

struct Epi {
  int type;
  int m0;
  short* dst;
  int ld;
  int col0;
  const float* ssq_in;
  float inv_k;
  float* ssq_out;
  const float* g;
  const float* kpe;
  short* kdst;
  short* vtdst;
  int head;
  const float* xold;
  const short* xoldb;
  float* xnew;
  float* fdst;
};

DI void store8_bf16(short* p, const float (&v)[8]) {
  u32x4 o;
  o[0] = pack_bf16(v[0], v[1]); o[1] = pack_bf16(v[2], v[3]); o[2] = pack_bf16(v[4], v[5]); o[3] = pack_bf16(v[6], v[7]);
  __builtin_nontemporal_store(o, (u32x4*)p);
}
DI float red8(float x) { x += __shfl_xor(x, 1); x += __shfl_xor(x, 2); x += __shfl_xor(x, 4); return x; }
DI float red16(float x) { x = red8(x); x += __shfl_xor(x, 8); return x; }

DI void tstore(const float* sf, int c0, int ncols, short* dst, size_t ldt) {
  for (int idx = my_tid() & 255; idx < ncols * 16; idx += 256) {
    int tg4 = idx & 3, c = (idx >> 2) % ncols, tgh = idx / (4 * ncols);
    int t0 = (tgh * 4 + tg4) * 8;
    const float* sp = sf + t0 * SF_LD + c0 + c;
    u32x4 o;
#pragma unroll
    for (int e = 0; e < 4; e++) o[e] = pack_bf16(sp[(2 * e) * SF_LD], sp[(2 * e + 1) * SF_LD]);
    *(u32x4*)(dst + (size_t)c * ldt + t0) = o;
  }
}

template <int TYPE>
DI void epi_rows(const Epi& e, float* sf, const u32x4 (&pre)[8], bool use_pre) {
  const int tid = my_tid() & 255, lane = tid & 63, w = tid >> 6;
  const int c8 = lane & 15, rsub = lane >> 4;
  const int q = c8 - 8;
#pragma unroll
  for (int bt = 0; bt < 2; bt++) {
    float ssq[4];
    f32x4 xo[4][2];
    f32x2 pea[4], peb[4];
    float gv[8];
#pragma unroll
    for (int s4 = 0; s4 < 4; s4++) {
      const int row = w * 32 + (bt * 4 + s4) * 4 + rsub;
      const int grow = e.m0 + row;
      ssq[s4] = (use_pre && TYPE != EPI_OUT) ? __uint_as_float(pre[bt * 4 + s4][0]) : (e.ssq_in ? e.ssq_in[grow] : 0.f);
      if (TYPE == EPI_OUT) {
        if (e.xoldb) {
          const u32x4 t = use_pre ? pre[bt * 4 + s4] : *(const u32x4*)(e.xoldb + (size_t)grow * 1024 + e.col0 + c8 * 8);
          xo[s4][0] = f32x4{bf_lo(t[0]), bf_hi(t[0]), bf_lo(t[1]), bf_hi(t[1])};
          xo[s4][1] = f32x4{bf_lo(t[2]), bf_hi(t[2]), bf_lo(t[3]), bf_hi(t[3])};
        } else {
          const float* xp = e.xold + (size_t)row * 1024 + e.col0 + c8 * 8;
          xo[s4][0] = *(const f32x4*)xp;
          xo[s4][1] = *(const f32x4*)(xp + 4);
        }
      }
      if (TYPE == EPI_KV) {
        const float* pp = e.kpe + (size_t)grow * 32 + 2 * (q & 7);
        pea[s4] = *(const f32x2*)pp;
        peb[s4] = *(const f32x2*)(pp + 16);
      }
    }
    if (TYPE == EPI_QMEM || TYPE == EPI_MEMK) {
#pragma unroll
      for (int c = 0; c < 8; c++) gv[c] = e.g[(c8 & 7) * 8 + c];
    }
    if (TYPE == EPI_KV) {
#pragma unroll
      for (int c = 0; c < 8; c++) gv[c] = e.g[(c8 & 7) * 8 + c];
    }
#pragma unroll
    for (int s4 = 0; s4 < 4; s4++) {
      const int row = w * 32 + (bt * 4 + s4) * 4 + rsub;
      const int grow = e.m0 + row;
      const float rs = e.ssq_in ? rsqrt_f(ssq[s4] * e.inv_k + EPS) : 1.f;
      float* rp = sf + row * SF_LD + c8 * 8;
      float v[8];
      {
        f32x4 t0 = *(const f32x4*)rp, t1 = *(const f32x4*)(rp + 4);
        v[0] = t0[0] * rs; v[1] = t0[1] * rs; v[2] = t0[2] * rs; v[3] = t0[3] * rs;
        v[4] = t1[0] * rs; v[5] = t1[1] * rs; v[6] = t1[2] * rs; v[7] = t1[3] * rs;
      }
      if (TYPE == EPI_BF16 || TYPE == EPI_BF16_SSQ || TYPE == EPI_GATE || TYPE == EPI_U) {
        if (TYPE == EPI_BF16_SSQ) {
          float ss = 0.f;
#pragma unroll
          for (int c = 0; c < 8; c++) ss += v[c] * v[c];
          ss = red16(ss);
          if (c8 == 0 && e.ssq_out) atomic_add_f(e.ssq_out + grow, ss);
        } else if (TYPE == EPI_GATE) {
#pragma unroll
          for (int c = 0; c < 8; c++) v[c] = silu_f(v[c]);
        } else if (TYPE == EPI_U) {
#pragma unroll
          for (int c = 0; c < 8; c++) v[c] = gelu_f(v[c]);
        }
        store8_bf16(e.dst + (size_t)grow * e.ld + e.col0 + c8 * 8, v);
      } else if (TYPE == EPI_QMEM || TYPE == EPI_MEMK) {
        float ss = 0.f;
#pragma unroll
        for (int c = 0; c < 8; c++) ss += v[c] * v[c];
        ss = red8(ss);
        float f = rsqrt_f(ss * (1.f / 64.f) + EPS);
        if (TYPE == EPI_QMEM) f *= 0.125f * LOG2E;
#pragma unroll
        for (int c = 0; c < 8; c++) v[c] *= f * gv[c];
        short* d = TYPE == EPI_MEMK ? e.dst + (size_t)(c8 >> 3) * 256 * 64 + (size_t)row * 64 + (c8 & 7) * 8
                                    : e.dst + (size_t)grow * e.ld + e.col0 + c8 * 8;
        store8_bf16(d, v);
      } else if (TYPE == EPI_KPE) {
        if (c8 < 4) {
          float* d = e.fdst + (size_t)grow * 32 + c8 * 8;
          f32x4 t0 = {v[0], v[1], v[2], v[3]}, t1 = {v[4], v[5], v[6], v[7]};
          *(f32x4*)d = t0;
          *(f32x4*)(d + 4) = t1;
        }
      } else if (TYPE == EPI_OUT) {
        f32x4 t0 = xo[s4][0], t1 = xo[s4][1];
        t0[0] += v[0]; t0[1] += v[1]; t0[2] += v[2]; t0[3] += v[3];
        t1[0] += v[4]; t1[1] += v[5]; t1[2] += v[6]; t1[3] += v[7];
        if (e.xnew) {
          float* xn = e.xnew + (size_t)grow * 1024 + e.col0 + c8 * 8;
          *(f32x4*)xn = t0;
          *(f32x4*)(xn + 4) = t1;
        }
        float ss = t0[0] * t0[0] + t0[1] * t0[1] + t0[2] * t0[2] + t0[3] * t0[3] + t1[0] * t1[0] + t1[1] * t1[1] + t1[2] * t1[2] + t1[3] * t1[3];
        if (e.dst) {
          float xv[8] = {t0[0], t0[1], t0[2], t0[3], t1[0], t1[1], t1[2], t1[3]};
          store8_bf16(e.dst + (size_t)grow * 1024 + e.col0 + c8 * 8, xv);
        }
        ss = red16(ss);
        if (c8 == 0 && e.ssq_out) atomic_add_f(e.ssq_out + grow, ss);
      } else if (TYPE == EPI_VT || TYPE == EPI_MEMV) {
        float ss = 0.f;
#pragma unroll
        for (int c = 0; c < 8; c++) {
          if (TYPE == EPI_VT) v[c] = gelu_f(v[c]);
          ss += v[c] * v[c];
        }
        f32x4 t0 = {v[0], v[1], v[2], v[3]}, t1 = {v[4], v[5], v[6], v[7]};
        *(f32x4*)rp = t0;
        *(f32x4*)(rp + 4) = t1;
        if (TYPE == EPI_VT) {
          ss = red16(ss);
          if (c8 == 0 && e.ssq_out) atomic_add_f(e.ssq_out + grow, ss);
        }
      } else {
        float ss = 0.f;
        if (c8 < 8) {
#pragma unroll
          for (int c = 0; c < 8; c++) ss += v[c] * v[c];
        } else {
          f32x4 t0 = {v[0], v[1], v[2], v[3]}, t1 = {v[4], v[5], v[6], v[7]};
          *(f32x4*)rp = t0;
          *(f32x4*)(rp + 4) = t1;
          ss = pea[s4][0] * pea[s4][0] + pea[s4][1] * pea[s4][1] + peb[s4][0] * peb[s4][0] + peb[s4][1] * peb[s4][1];
        }
        ss = red16(ss);
        const float f = rsqrt_f(ss * (1.f / 96.f) + EPS);
        short* kd = e.kdst + ((size_t)e.head * T + grow) * 96;
        if (c8 < 8) {
#pragma unroll
          for (int c = 0; c < 8; c++) v[c] *= f * gv[c];
          store8_bf16(kd + c8 * 8, v);
        } else {
          const int pos = tok_pos(grow);
          float o1[2], o2[2];
#pragma unroll
          for (int t = 0; t < 2; t++) {
            int i = 2 * q + t;
            float cs, sn;
            rope_cs(pos, i, cs, sn);
            float x1 = pea[s4][t] * f * e.g[64 + i], x2 = peb[s4][t] * f * e.g[80 + i];
            o1[t] = x1 * cs - x2 * sn;
            o2[t] = x1 * sn + x2 * cs;
          }
          *(unsigned*)(kd + 64 + 2 * q) = pack_bf16(o1[0], o1[1]);
          *(unsigned*)(kd + 80 + 2 * q) = pack_bf16(o2[0], o2[1]);
        }
      }
    }
  }
}

DI void gemm_epilogue(const Epi& e, char* smem, const u32x4 (&pre)[8], bool use_pre);
DI void gemm_epilogue(const Epi& e, char* smem) {
  u32x4 none[8];
#pragma unroll
  for (int i = 0; i < 8; i++) none[i] = u32x4{0u, 0u, 0u, 0u};
  gemm_epilogue(e, smem, none, false);
}
DI void gemm_epilogue(const Epi& e, char* smem, const u32x4 (&pre)[8], bool use_pre) {
  float* sf = (float*)(smem + ((my_tid() >> 8) & 1) * SF_BYTES);
  const int type = e.type;
  switch (type) {
    case EPI_BF16: epi_rows<EPI_BF16>(e, sf, pre, use_pre); break;
    case EPI_BF16_SSQ: epi_rows<EPI_BF16_SSQ>(e, sf, pre, use_pre); break;
    case EPI_QMEM: epi_rows<EPI_QMEM>(e, sf, pre, use_pre); break;
    case EPI_GATE: epi_rows<EPI_GATE>(e, sf, pre, use_pre); break;
    case EPI_KPE: epi_rows<EPI_KPE>(e, sf, pre, use_pre); break;
    case EPI_KV: epi_rows<EPI_KV>(e, sf, pre, use_pre); break;
    case EPI_OUT: epi_rows<EPI_OUT>(e, sf, pre, use_pre); break;
    case EPI_U: epi_rows<EPI_U>(e, sf, pre, use_pre); break;
    case EPI_VT: epi_rows<EPI_VT>(e, sf, pre, use_pre); break;
    case EPI_MEMK: epi_rows<EPI_MEMK>(e, sf, pre, use_pre); break;
    case EPI_MEMV: epi_rows<EPI_MEMV>(e, sf, pre, use_pre); break;
    default: break;
  }
  __syncthreads();
  if (type == EPI_KV) tstore(sf, 64, 64, e.vtdst + (size_t)e.head * 64 * T + e.m0, (size_t)T);
  else if (type == EPI_VT) tstore(sf, 0, 128, e.dst + (size_t)e.col0 * T + e.m0, (size_t)T);
  else if (type == EPI_MEMV) tstore(sf, 0, 128, e.dst, 256);
  __syncthreads();
}

#define SGB(mask, n) __builtin_amdgcn_sched_group_barrier((mask), (n), 0)
template <int DK>
DI void attn_core(const bf16x8 (&qf)[DK / 16], const short* Kg, const short* VTg, size_t ldvt, int ntiles, char* smem,
                  f32x16 (&O)[2], float& lsum) {
  constexpr int KROW = DK * 2 + 16;
  constexpr int KT_BYTES = 128 * KROW;
  constexpr int VROW = 272;
  constexpr int ST = KT_BYTES + 64 * VROW;
  constexpr int KCH = DK / 8;
  constexpr int NKC = 128 * KCH / 512;
  constexpr int NKS = DK / 16;
  const int tid = my_tid(), lane = tid & 63, r = lane & 31, h = lane >> 5;
  const int pr = (r & ~12) | ((r & 4) << 1) | ((r & 8) >> 1);
  u32x4 kreg[NKC], vreg[2];
  int koff[NKC];
#pragma unroll
  for (int i = 0; i < NKC; i++) { int c = tid + 512 * i; koff[i] = (c / KCH) * KROW + (c % KCH) * 16; }
  const int vrow = tid >> 4, vcol = tid & 15;
  const short* vg = VTg + (size_t)vrow * ldvt + vcol * 8;
  const int voff = KT_BYTES + vrow * VROW + vcol * 16;
#pragma unroll
  for (int i = 0; i < 16; i++) { O[0][i] = 0.f; O[1][i] = 0.f; }
  float l0 = 0.f;

#define AGLOAD(t)                                                                              \
  {                                                                                            \
    _Pragma("unroll") for (int i = 0; i < NKC; i++) kreg[i] = *(const u32x4*)(Kg + (size_t)(t) * 128 * DK + (tid + 512 * i) * 8); \
    _Pragma("unroll") for (int i = 0; i < 2; i++) vreg[i] = *(const u32x4*)(vg + (size_t)(32 * i) * ldvt + (t) * 128); \
  }
#define ASTORE(s)                                                                              \
  {                                                                                            \
    char* sk_ = smem + (s) * ST;                                                               \
    _Pragma("unroll") for (int i = 0; i < NKC; i++) *(u32x4*)(sk_ + koff[i]) = kreg[i];        \
    _Pragma("unroll") for (int i = 0; i < 2; i++) *(u32x4*)(sk_ + voff + 32 * i * VROW) = vreg[i]; \
  }
#define SOFTMAX(S, pa, pb, lacc)                                                               \
  {                                                                                            \
    float p_[16];                                                                              \
    _Pragma("unroll") for (int i = 0; i < 16; i++) { p_[i] = exp2_f(S[i]); lacc += p_[i]; }   \
    u32x4 a_, b_;                                                                              \
    _Pragma("unroll") for (int q = 0; q < 4; q++) { a_[q] = pack_bf16(p_[2 * q], p_[2 * q + 1]); b_[q] = pack_bf16(p_[8 + 2 * q], p_[8 + 2 * q + 1]); } \
    pa = __builtin_bit_cast(bf16x8, a_);                                                       \
    pb = __builtin_bit_cast(bf16x8, b_);                                                       \
  }
#define KLOAD(kf_, base)                                                                       \
  { _Pragma("unroll") for (int ks = 0; ks < NKS; ks++) kf_[ks] = *(const bf16x8*)((base) + kfo + ks * 32); }
#define VLOAD(vf_, base)                                                                       \
  { _Pragma("unroll") for (int q = 0; q < 4; q++) vf_[q] = *(const bf16x8*)((base) + vfo + (q >> 1) * 32 * VROW + (q & 1) * 32); }
#define QKM(dst, kf_)                                                                          \
  {                                                                                            \
    _Pragma("unroll") for (int i = 0; i < 16; i++) dst[i] = 0.f;                               \
    _Pragma("unroll") for (int ks = 0; ks < NKS; ks++) dst = MFMA(kf_[ks], qf[ks], dst);       \
  }
#define PVM(vf_, pa, pb)                                                                       \
  {                                                                                            \
    O[0] = MFMA(vf_[0], pa, O[0]);                                                             \
    O[1] = MFMA(vf_[2], pa, O[1]);                                                             \
    O[0] = MFMA(vf_[1], pb, O[0]);                                                             \
    O[1] = MFMA(vf_[3], pb, O[1]);                                                             \
  }
#define SB() __builtin_amdgcn_sched_barrier(0)
  const int kfo = pr * KROW + h * 16;
  const int vfo = KT_BYTES + r * VROW + h * 16;
  AGLOAD(0);
  ASTORE(0);
  AGLOAD(ntiles > 1 ? 1 : 0);
  ASTORE(1);
  __syncthreads();
  f32x16 Sc;
  {
    bf16x8 kf[NKS];
    KLOAD(kf, smem);
    QKM(Sc, kf);
  }
  int sc = 0, sn = 1, sw = 2;
  for (int t = 0; t < ntiles; t++) {
    const int tn = t + 2 < ntiles ? t + 2 : ntiles - 1;
    AGLOAD(tn);
    const char* cur = smem + sc * ST;
    const char* nxt = smem + sn * ST;
    f32x16 Sn;
    bf16x8 pa, pb, qa, qb;
    bf16x8 kf[NKS], vf[4];
    KLOAD(kf, cur + 32 * KROW);
    SB();
    SOFTMAX(Sc, pa, pb, l0);
    SB();
    QKM(Sn, kf);
    SB();
    KLOAD(kf, cur + 64 * KROW);
    VLOAD(vf, cur);
    SB();
    SOFTMAX(Sn, qa, qb, l0);
    SB();
    QKM(Sc, kf);
    PVM(vf, pa, pb);
    SB();
    KLOAD(kf, cur + 96 * KROW);
    VLOAD(vf, cur + 64);
    SB();
    SOFTMAX(Sc, pa, pb, l0);
    SB();
    QKM(Sn, kf);
    PVM(vf, qa, qb);
    SB();
    KLOAD(kf, nxt);
    VLOAD(vf, cur + 128);
    SB();
    SOFTMAX(Sn, qa, qb, l0);
    SB();
    QKM(Sc, kf);
    PVM(vf, pa, pb);
    SB();
    VLOAD(vf, cur + 192);
    PVM(vf, qa, qb);
    ASTORE(sw);
    __syncthreads();
    const int tmp = sc; sc = sn; sn = sw; sw = tmp;
  }
  lsum = l0;
#undef AGLOAD
#undef ASTORE
#undef SOFTMAX
#undef KLOAD
#undef VLOAD
#undef QKM
#undef PVM
#undef SB
}

DI void attn_store(const f32x16 (&O)[2], float lsum, int tok, int col0, const short* gate, short* o, char* smem) {
  const int tid = my_tid(), lane = tid & 63, w = tid >> 6, r = lane & 31, h = lane >> 5;
  float l = lsum + __shfl_xor(lsum, 32);
  float inv = __builtin_amdgcn_rcpf(l);
  float* pw = (float*)(smem + w * (32 * 68 * 4));
  const int tokw = tok - r;
  const int ch = lane & 7;
  u32x4 gpre[4];
#pragma unroll
  for (int j = 0; j < 4; j++) gpre[j] = *(const u32x4*)(gate + (size_t)(tokw + j * 8 + (lane >> 3)) * 1024 + col0 + ch * 8);
#pragma unroll
  for (int dt = 0; dt < 2; dt++)
#pragma unroll
    for (int q = 0; q < 4; q++) {
      f32x4 t = {O[dt][q * 4 + 0] * inv, O[dt][q * 4 + 1] * inv, O[dt][q * 4 + 2] * inv, O[dt][q * 4 + 3] * inv};
      *(f32x4*)(pw + r * 68 + dt * 32 + 8 * q + 4 * h) = t;
    }
  asm volatile("s_waitcnt lgkmcnt(0)" ::: "memory");
#pragma unroll
  for (int j = 0; j < 4; j++) {
    const int row = j * 8 + (lane >> 3);
    const size_t g = (size_t)(tokw + row) * 1024 + col0 + ch * 8;
    const u32x4 gv = gpre[j];
    const f32x4 a = *(const f32x4*)(pw + row * 68 + ch * 8), c = *(const f32x4*)(pw + row * 68 + ch * 8 + 4);
    u32x4 ov;
    ov[0] = pack_bf16(a[0] * bf_lo(gv[0]), a[1] * bf_hi(gv[0]));
    ov[1] = pack_bf16(a[2] * bf_lo(gv[1]), a[3] * bf_hi(gv[1]));
    ov[2] = pack_bf16(c[0] * bf_lo(gv[2]), c[1] * bf_hi(gv[2]));
    ov[3] = pack_bf16(c[2] * bf_lo(gv[3]), c[3] * bf_hi(gv[3]));
    __builtin_nontemporal_store(ov, (u32x4*)(o + g));
  }
  __syncthreads();
}

DI void mla_item(PRef p, int j, int seq, int head, int qb, char* smem) {
  const int tid = my_tid(), lane = tid & 63, w = tid >> 6, r = lane & 31, h = lane >> 5;
  const int s0 = seq == 0 ? 0 : TP + (seq - 1) * SS;
  const int S = seq == 0 ? TP : SS;
  const int pos = qb * 256 + w * 32 + r;
  const int tok = s0 + pos;
  const short* Q = (const short*)(p.ws + OFF_Q);
  const float* gq = p.in[10] + j * 96;
  float qv[6][8];
  float ss = 0.f;
#pragma unroll
  for (int ks = 0; ks < 6; ks++) {
    u32x4 t = *(const u32x4*)(Q + (size_t)tok * 1152 + head * 96 + ks * 16 + 8 * h);
#pragma unroll
    for (int e = 0; e < 4; e++) {
      qv[ks][2 * e] = bf_lo(t[e]);
      qv[ks][2 * e + 1] = bf_hi(t[e]);
    }
#pragma unroll
    for (int e = 0; e < 8; e++) ss += qv[ks][e] * qv[ks][e];
  }
  ss += __shfl_xor(ss, 32);
  const float f = rsqrt_f(ss * (1.f / 96.f) + EPS);
  const float sc = 0.10206207261596575f * LOG2E;
#pragma unroll
  for (int ks = 0; ks < 6; ks++)
#pragma unroll
    for (int e = 0; e < 8; e++) qv[ks][e] *= f * gq[ks * 16 + 8 * h + e];
#pragma unroll
  for (int e = 0; e < 8; e++) {
    float cs, sn;
    rope_cs(pos, 8 * h + e, cs, sn);
    float x1 = qv[4][e], x2 = qv[5][e];
    qv[4][e] = x1 * cs - x2 * sn;
    qv[5][e] = x1 * sn + x2 * cs;
  }
  bf16x8 qf[6];
#pragma unroll
  for (int ks = 0; ks < 6; ks++) {
    u32x4 t;
#pragma unroll
    for (int e = 0; e < 4; e++) t[e] = pack_bf16(qv[ks][2 * e] * sc, qv[ks][2 * e + 1] * sc);
    qf[ks] = __builtin_bit_cast(bf16x8, t);
  }
  f32x16 O[2];
  float lsum;
  const short* Kg = (const short*)(p.ws + OFF_K) + ((size_t)head * T + s0) * 96;
  const short* VTg = (const short*)(p.ws + OFF_VT) + (size_t)head * 64 * T + s0;
  attn_core<96>(qf, Kg, VTg, (size_t)T, S >> 7, smem, O, lsum);
  attn_store(O, lsum, tok, head * 64, (const short*)(p.ws + OFF_GATE), (short*)(p.ws + OFF_O), smem);
}

DI void memattn_item(PRef p, int layer, int mt, int head, char* smem) {
  const int tid = my_tid(), lane = tid & 63, w = tid >> 6, r = lane & 31, h = lane >> 5;
  const int tok = mt * 256 + w * 32 + r;
  const int seq = tok_seq(mt * 256);
  const short* Q = (const short*)(p.ws + OFF_QMEM);
  bf16x8 qf[4];
#pragma unroll
  for (int ks = 0; ks < 4; ks++) qf[ks] = *(const bf16x8*)(Q + (size_t)tok * 256 + head * 64 + ks * 16 + 8 * h);
  const size_t hb = ((size_t)(layer * NSEQ + seq) * 4 + head) * 256 * 64;
  f32x16 O[2];
  float lsum;
  attn_core<64>(qf, (const short*)(p.ws + OFF_KMEM) + hb, (const short*)(p.ws + OFF_VMEM) + hb, 256, 2, smem, O, lsum);
  attn_store(O, lsum, tok, 768 + head * 64, (const short*)(p.ws + OFF_GATE), (short*)(p.ws + OFF_O), smem);
}

DI void sgu_item(PRef p, int jb, int pair, char* smem) {
  constexpr int WROW = 272;
  const int tid_ = my_tid(), hb_ = tid_ >> 8;
  const int tid = tid_ & 255, lane = tid & 63, w = tid >> 6, r = lane & 31, h = lane >> 5;
  const int item = pair * 2 + hb_, chunk = item >> 3, g = item & 7;
  smem += hb_ * 60928;
  char* sw = smem;
  char* sv = smem + 128 * WROW;
  const int tok0 = chunk * 128;
  u32x4 upre[6], gpre[6];
#pragma unroll
  for (int i = 0; i < 6; i++) {
    const int idx = tid + 256 * i, row = idx / 12, ch = idx - row * 12;
    upre[i] = *(const u32x4*)((const short*)(p.ws + OFF_U) + (size_t)(tok0 + row) * 768 + g * 96 + ch * 8);
    gpre[i] = *(const u32x4*)((const short*)(p.ws + OFF_GATE) + (size_t)(tok0 + row) * 1024 + g * 96 + ch * 8);
  }
  const short* Ws = (const short*)(p.ws + OFF_WS) + (size_t)(jb * 8 + g) * 128 * 128;
  const short* VT = (const short*)(p.ws + OFF_K);
  const float* ssqv = (const float*)(p.ws + OFF_SSQ) + (size_t)(8 + jb) * T;
  const float* vg = p.in[13] + jb * 768 + g * 96;
#pragma unroll
  for (int i = 0; i < 8; i++) {
    int c = tid + 256 * i, row = c >> 4, col = c & 15;
    *(u32x4*)(sw + row * WROW + col * 16) = *(const u32x4*)(Ws + row * 128 + col * 8);
  }
#pragma unroll
  for (int i = 0; i < 6; i++) {
    int c = tid + 256 * i, row = c >> 4, col = c & 15;
    u32x4 t = *(const u32x4*)(VT + (size_t)(g * 96 + row) * T + tok0 + col * 8);
    const float gg = vg[row];
    const float* sq = ssqv + tok0 + col * 8;
    u32x4 o;
#pragma unroll
    for (int e = 0; e < 4; e++) {
      float r0 = rsqrt_f(sq[2 * e] * (1.f / 768.f) + EPS), r1 = rsqrt_f(sq[2 * e + 1] * (1.f / 768.f) + EPS);
      o[e] = pack_bf16(bf_lo(t[e]) * r0 * gg, bf_hi(t[e]) * r1 * gg);
    }
    *(u32x4*)(sv + row * WROW + col * 16) = o;
  }
  __syncthreads();
  f32x16 acc[3];
#pragma unroll
  for (int n = 0; n < 3; n++)
#pragma unroll
    for (int i = 0; i < 16; i++) acc[n][i] = 0.f;
  const char* ap = sw + (w * 32 + r) * WROW + h * 16;
  const char* bp = sv + r * WROW + h * 16;
#pragma unroll
  for (int ks = 0; ks < 8; ks++) {
    bf16x8 a = *(const bf16x8*)(ap + ks * 32);
#pragma unroll
    for (int n = 0; n < 3; n++) {
      bf16x8 b = *(const bf16x8*)(bp + n * 32 * WROW + ks * 32);
      acc[n] = MFMA(a, b, acc[n]);
    }
  }
  __syncthreads();
  float* sf = (float*)smem;
#pragma unroll
  for (int n = 0; n < 3; n++)
#pragma unroll
    for (int i = 0; i < 16; i++) {
      int row = w * 32 + (i & 3) + 8 * (i >> 2) + 4 * h;
      sf[row * 100 + n * 32 + r] = acc[n][i];
    }
  __syncthreads();
  {
#pragma unroll
    for (int i = 0; i < 6; i++) {
      const int idx = tid + 256 * i, row = idx / 12, ch = idx - row * 12;
      const int tok = tok0 + row;
      const float bias = p.in[15][(size_t)(jb * 8 + g) * 128 + row];
      const u32x4 uu = upre[i], gg = gpre[i];
      const float* mp = sf + row * 100 + ch * 8;
      const f32x4 m0 = *(const f32x4*)mp, m1 = *(const f32x4*)(mp + 4);
      u32x4 o;
      o[0] = pack_bf16((m0[0] + bias) * bf_lo(uu[0]) * bf_lo(gg[0]), (m0[1] + bias) * bf_hi(uu[0]) * bf_hi(gg[0]));
      o[1] = pack_bf16((m0[2] + bias) * bf_lo(uu[1]) * bf_lo(gg[1]), (m0[3] + bias) * bf_hi(uu[1]) * bf_hi(gg[1]));
      o[2] = pack_bf16((m1[0] + bias) * bf_lo(uu[2]) * bf_lo(gg[2]), (m1[1] + bias) * bf_hi(uu[2]) * bf_hi(gg[2]));
      o[3] = pack_bf16((m1[2] + bias) * bf_lo(uu[3]) * bf_lo(gg[3]), (m1[3] + bias) * bf_hi(uu[3]) * bf_hi(gg[3]));
      __builtin_nontemporal_store(o, (u32x4*)((short*)(p.ws + OFF_O) + (size_t)tok * 1024 + g * 96 + ch * 8));
    }
  }
  __syncthreads();
}

DI void conv_w(const float* W, int K, int Nsrc, int Ndst, const float* g, short* dst, int remap, int gtid, int gthreads) {
  asm volatile("" : "+s"(gthreads));
  const int kgs = K >> 3;
  const int total = Ndst * kgs;
  for (int idx = gtid; idx < total; idx += gthreads) {
    int n = idx % Ndst, kg = idx / Ndst;
    int src = n;
    if (remap) src = n < 640 ? n : (n < 1920 ? n + 32 : (n < 1952 ? n - 1280 : -1));
    float v[8];
#pragma unroll
    for (int e = 0; e < 8; e++) {
      int k = kg * 8 + e;
      float x = src >= 0 ? W[(size_t)k * Nsrc + src] : 0.f;
      if (g) x *= g[k];
      v[e] = x;
    }
    u32x4 o;
#pragma unroll
    for (int e = 0; e < 4; e++) o[e] = pack_bf16(v[2 * e], v[2 * e + 1]);
    *(u32x4*)(dst + (size_t)n * K + kg * 8) = o;
  }
}

DI void phase_prep(PRef p) {
  const int tid0 = my_tid();
  const int gtid = blockIdx.x * 512 + tid0, gthreads = gridDim.x * 512;
  char* ws = p.ws;
  for (int j = 0; j < 2; j++) {
    conv_w(p.in[5] + (size_t)j * 1024 * 1952, 1024, 1952, 2048, p.in[4] + (2 * j) * 1024, (short*)(ws + OFF_WIA) + (size_t)j * 2048 * 1024, 1, gtid, gthreads);
    conv_w(p.in[12] + (size_t)j * 1024 * 2816, 1024, 2816, 2816, p.in[4] + (2 * j + 1) * 1024, (short*)(ws + OFF_WIB) + (size_t)j * 2816 * 1024, 0, gtid, gthreads);
    conv_w(p.in[8] + (size_t)j * 384 * 1152, 384, 1152, 1152, p.in[6] + j * 384, (short*)(ws + OFF_WUQ) + (size_t)j * 1152 * 384, 0, gtid, gthreads);
    conv_w(p.in[9] + (size_t)j * 256 * 1536, 256, 1536, 1536, p.in[7] + j * 256, (short*)(ws + OFF_WUKV) + (size_t)j * 1536 * 256, 0, gtid, gthreads);
  }
  for (int i = 0; i < 4; i++) {
    conv_w(p.in[17] + (size_t)i * 1024 * 512, 1024, 512, 512, p.in[16] + i * 1024, (short*)(ws + OFF_WMKV) + (size_t)i * 512 * 1024, 0, gtid, gthreads);
    conv_w(p.in[20] + (size_t)i * 1024 * 1024, 1024, 1024, 1024, nullptr, (short*)(ws + OFF_WOUT) + (size_t)i * 1024 * 1024, 0, gtid, gthreads);
  }
  {
    const float* src = p.in[14];
    unsigned* dst = (unsigned*)(ws + OFF_WS);
    for (int idx = gtid; idx < 2 * 8 * 128 * 128 / 2; idx += gthreads) dst[idx] = pack_bf16(src[2 * idx], src[2 * idx + 1]);
  }
  {
    float* z = (float*)(ws + OFF_SSQ) + T;
    for (int idx = gtid; idx < 9 * T; idx += gthreads) z[idx] = 0.f;
  }
  {
    const int gw = gtid >> 6, nw = gthreads >> 6, lane = tid0 & 63;
    float* ssqx = (float*)(ws + OFF_SSQ);
    float* ssqm = (float*)(ws + OFF_SSQM);
    for (int row = gw; row < T + MEMROWS; row += nw) {
      const float* src;
      short* dstb;
      if (row < TP) src = p.in[0] + (size_t)row * 1024;
      else if (row < T) src = p.in[1] + (size_t)(row - TP) * 1024;
      else if (row < T + 256) src = p.in[2] + (size_t)(row - T) * 1024;
      else src = p.in[3] + (size_t)(row - T - 256) * 1024;
      if (row < T) dstb = (short*)(ws + OFF_XB) + (size_t)row * 1024;
      else dstb = (short*)(ws + OFF_MEMB) + (size_t)(row - T) * 1024;
      float ss = 0.f;
#pragma unroll
      for (int c = 0; c < 2; c++) {
        f32x4 v0 = *(const f32x4*)(src + c * 512 + lane * 8);
        f32x4 v1 = *(const f32x4*)(src + c * 512 + lane * 8 + 4);
        ss += v0[0] * v0[0] + v0[1] * v0[1] + v0[2] * v0[2] + v0[3] * v0[3] + v1[0] * v1[0] + v1[1] * v1[1] + v1[2] * v1[2] + v1[3] * v1[3];
        u32x4 o;
        o[0] = pack_bf16(v0[0], v0[1]); o[1] = pack_bf16(v0[2], v0[3]); o[2] = pack_bf16(v1[0], v1[1]); o[3] = pack_bf16(v1[2], v1[3]);
        *(u32x4*)(dstb + c * 512 + lane * 8) = o;
      }
#pragma unroll
      for (int o = 32; o >= 1; o >>= 1) ss += __shfl_xor(ss, o);
      if (lane == 0) {
        if (row < T) ssqx[row] = ss; else ssqm[row - T] = ss;
      }
    }
  }
}

DI void prefetch_ssq(u32x4 (&pre)[8], const float* ssq, int m0) {
  const int t_ = my_tid() & 255, ln_ = t_ & 63, ww_ = t_ >> 6;
#pragma unroll
  for (int s_ = 0; s_ < 8; s_++) pre[s_] = u32x4{__float_as_uint(ssq[m0 + ww_ * 32 + s_ * 4 + (ln_ >> 4)]), 0u, 0u, 0u};
}

DI short* xb_ptr(PRef p, int layer) { return (layer == 1 || layer == 2) ? (short*)p.out : (short*)(p.ws + OFF_XB); }
DI const float* x_rows(PRef p, int layer, int m0) {
  if (layer == 0) return m0 < TP ? p.in[0] + (size_t)m0 * 1024 : p.in[1] + (size_t)(m0 - TP) * 1024;
  return p.out + (size_t)m0 * 1024;
}

DI void memkv_tile(PRef p, int it, char* smem) {
  const int layer = it / 34, rem = it % 34, mt = rem >> 1, nt2 = rem & 1;
  const short* A = (const short*)(p.ws + OFF_MEMB) + (size_t)mt * 256 * 1024;
  const short* B = (const short*)(p.ws + OFF_WMKV) + ((size_t)layer * 512 + nt2 * 256) * 1024;
  f32x16 acc[4][2];
  gemm_main<false>(A, 1024, B, 1024, smem, acc);
  const int nt = nt2 * 2 + (my_tid() >> 8);
#pragma unroll
  for (int pm = 0; pm < 2; pm++) {
    u32x4 pre[8];
    prefetch_ssq(pre, (const float*)(p.ws + OFF_SSQM), mt * 256 + pm * 128);
    stage_half(acc, pm, smem);
    const int m0 = mt * 256 + pm * 128;
    Epi e{};
    e.m0 = m0;
    e.ssq_in = (const float*)(p.ws + OFF_SSQM);
    e.inv_k = 1.f / 1024.f;
    const int seq = m0 >> 8, key0 = m0 & 255;
    const int head0 = (nt & 1) * 2;
    const size_t hb = ((size_t)(layer * NSEQ + seq) * 4 + head0) * 256 * 64;
    if (nt < 2) {
      e.type = EPI_MEMK;
      e.g = p.in[19] + layer * 64;
      e.dst = (short*)(p.ws + OFF_KMEM) + hb + (size_t)key0 * 64;
    } else {
      e.type = EPI_MEMV;
      e.dst = (short*)(p.ws + OFF_VMEM) + hb + key0;
    }
    gemm_epilogue(e, smem, pre, true);
  }
}

DI void inproj_a_tile(PRef p, int layer, int mt, int nt2, char* smem, int noatom) {
  const int j = layer >> 1;
  const short* B = (const short*)(p.ws + OFF_WIA) + ((size_t)j * 2048 + nt2 * 256) * 1024;
  f32x16 acc[4][2];
  gemm_main<false>(xb_ptr(p, layer) + (size_t)mt * 256 * 1024, 1024, B, 1024, smem, acc);
  const int nt = nt2 * 2 + (my_tid() >> 8);
#pragma unroll
  for (int pm = 0; pm < 2; pm++) {
    u32x4 pre[8];
    prefetch_ssq(pre, (const float*)(p.ws + OFF_SSQ) + (size_t)layer * T, mt * 256 + pm * 128);
    stage_half(acc, pm, smem);
    Epi e{};
    e.m0 = mt * 256 + pm * 128;
    e.ssq_in = (const float*)(p.ws + OFF_SSQ) + (size_t)layer * T;
    e.inv_k = 1.f / 1024.f;
    if (nt < 3) {
      e.type = EPI_BF16_SSQ; e.dst = (short*)(p.ws + OFF_QLAT); e.ld = 384; e.col0 = nt * 128;
      e.ssq_out = (float*)(p.ws + OFF_SSQ) + (size_t)(4 + j) * T;
    } else if (nt < 5) {
      e.type = EPI_BF16_SSQ; e.dst = (short*)(p.ws + OFF_KVLAT); e.ld = 256; e.col0 = (nt - 3) * 128;
      e.ssq_out = (float*)(p.ws + OFF_SSQ) + (size_t)(6 + j) * T;
    } else if (nt < 7) {
      e.type = EPI_QMEM; e.dst = (short*)(p.ws + OFF_QMEM); e.ld = 256; e.col0 = (nt - 5) * 128; e.g = p.in[18] + layer * 64;
    } else if (nt < 15) {
      e.type = EPI_GATE; e.dst = (short*)(p.ws + OFF_GATE); e.ld = 1024; e.col0 = (nt - 7) * 128;
    } else {
      e.type = EPI_KPE; e.fdst = (float*)(p.ws + OFF_KPE);
    }
    if (noatom) e.ssq_out = nullptr;
    gemm_epilogue(e, smem, pre, true);
  }
}

DI void inproj_b_tile(PRef p, int layer, int mt, int nt2, char* smem, int noatom) {
  const int j = layer >> 1;
  const short* B = (const short*)(p.ws + OFF_WIB) + ((size_t)j * 2816 + nt2 * 256) * 1024;
  f32x16 acc[4][2];
  gemm_main<false>(xb_ptr(p, layer) + (size_t)mt * 256 * 1024, 1024, B, 1024, smem, acc);
  const int nt = nt2 * 2 + (my_tid() >> 8);
#pragma unroll
  for (int pm = 0; pm < 2; pm++) {
    u32x4 pre[8];
    prefetch_ssq(pre, (const float*)(p.ws + OFF_SSQ) + (size_t)layer * T, mt * 256 + pm * 128);
    stage_half(acc, pm, smem);
    Epi e{};
    e.m0 = mt * 256 + pm * 128;
    e.ssq_in = (const float*)(p.ws + OFF_SSQ) + (size_t)layer * T;
    e.inv_k = 1.f / 1024.f;
    if (nt < 6) {
      e.type = EPI_U; e.dst = (short*)(p.ws + OFF_U); e.ld = 768; e.col0 = nt * 128;
    } else if (nt < 12) {
      e.type = EPI_VT; e.dst = (short*)(p.ws + OFF_K); e.col0 = (nt - 6) * 128;
      e.ssq_out = (float*)(p.ws + OFF_SSQ) + (size_t)(8 + j) * T;
    } else if (nt < 14) {
      e.type = EPI_QMEM; e.dst = (short*)(p.ws + OFF_QMEM); e.ld = 256; e.col0 = (nt - 12) * 128; e.g = p.in[18] + layer * 64;
    } else {
      e.type = EPI_GATE; e.dst = (short*)(p.ws + OFF_GATE); e.ld = 1024; e.col0 = (nt - 14) * 128;
    }
    if (noatom) e.ssq_out = nullptr;
    gemm_epilogue(e, smem, pre, true);
  }
}

DI void upproj_tile(PRef p, int layer, int mt, int nt2, char* smem) {
  const int j = layer >> 1;
  f32x16 acc[4][2];
  if (nt2 < 5) {
    const short* A = (const short*)(p.ws + OFF_QLAT) + (size_t)mt * 256 * 384;
    const short* B = (const short*)(p.ws + OFF_WUQ) + ((size_t)j * 1152 + nt2 * 256) * 384;
    gemm_main<false>(A, 384, B, 384, smem, acc);
  } else {
    const short* A = (const short*)(p.ws + OFF_KVLAT) + (size_t)mt * 256 * 256;
    const short* B = (const short*)(p.ws + OFF_WUKV) + ((size_t)j * 1536 + (nt2 - 5) * 256) * 256;
    gemm_main<false>(A, 256, B, 256, smem, acc);
  }
  const int hbk = my_tid() >> 8;
#pragma unroll
  for (int pm = 0; pm < 2; pm++) {
    u32x4 pre[8];
    prefetch_ssq(pre, (const float*)(p.ws + OFF_SSQ) + (size_t)((nt2 < 5 ? 4 : 6) + j) * T, mt * 256 + pm * 128);
    stage_half(acc, pm, smem);
    Epi e{};
    e.m0 = mt * 256 + pm * 128;
    if (nt2 < 5) {
      const int nt = nt2 * 2 + hbk;
      e.type = nt < 9 ? EPI_BF16 : EPI_NONE; e.dst = (short*)(p.ws + OFF_Q); e.ld = 1152; e.col0 = nt * 128;
      e.ssq_in = (const float*)(p.ws + OFF_SSQ) + (size_t)(4 + j) * T;
      e.inv_k = 1.f / 384.f;
    } else {
      e.type = EPI_KV;
      e.ssq_in = (const float*)(p.ws + OFF_SSQ) + (size_t)(6 + j) * T;
      e.inv_k = 1.f / 256.f;
      e.kpe = (const float*)(p.ws + OFF_KPE);
      e.g = p.in[11] + j * 96;
      e.kdst = (short*)(p.ws + OFF_K);
      e.vtdst = (short*)(p.ws + OFF_VT);
      e.head = (nt2 - 5) * 2 + hbk;
    }
    gemm_epilogue(e, smem, pre, true);
  }
}

DI void outproj_tile(PRef p, int layer, int mt, int nt2, char* smem, int noatom) {
  const short* A = (const short*)(p.ws + OFF_O) + (size_t)mt * 256 * 1024;
  const short* B = (const short*)(p.ws + OFF_WOUT) + ((size_t)layer * 1024 + nt2 * 256) * 1024;
  f32x16 acc[4][2];
  gemm_main<false>(A, 1024, B, 1024, smem, acc);
  const int nt = nt2 * 2 + (my_tid() >> 8);
#pragma unroll
  for (int pm = 0; pm < 2; pm++) {
    u32x4 pre[8];
#pragma unroll
    for (int s_ = 0; s_ < 8; s_++) pre[s_] = u32x4{0u, 0u, 0u, 0u};
    if (layer > 0) {
      const short* xb = xb_ptr(p, layer);
      const int t_ = my_tid() & 255, ln_ = t_ & 63, ww_ = t_ >> 6;
#pragma unroll
      for (int s_ = 0; s_ < 8; s_++) {
        const int row_ = ww_ * 32 + s_ * 4 + (ln_ >> 4);
        pre[s_] = *(const u32x4*)(xb + (size_t)(mt * 256 + pm * 128 + row_) * 1024 + nt * 128 + (ln_ & 15) * 8);
      }
    }
    stage_half(acc, pm, smem);
    Epi e{};
    e.type = EPI_OUT;
    e.m0 = mt * 256 + pm * 128;
    e.col0 = nt * 128;
    e.xold = layer == 0 ? x_rows(p, 0, e.m0) : nullptr;
    e.xoldb = layer == 0 ? nullptr : xb_ptr(p, layer);
    e.xnew = layer == 3 ? p.out : nullptr;
    e.dst = layer < 3 ? xb_ptr(p, layer + 1) : nullptr;
    e.ssq_out = (layer < 3 && !noatom) ? (float*)(p.ws + OFF_SSQ) + (size_t)(layer + 1) * T : nullptr;
    gemm_epilogue(e, smem, pre, layer > 0);
  }
}

DI bool gemm_tile_at(int k, int NT, int G, int& mt, int& nt) {
  const int xcd = blockIdx.x & 7, l = blockIdx.x >> 3, nl = gridDim.x >> 3;
  const int li = l + k * nl;
  if (li >= 40 * NT) return false;
  const int ng = li / (40 * G);
  const int rem = li - ng * 40 * G;
  const int gsz = min(G, NT - ng * G);
  const int lm = rem / gsz;
  mt = lm * 8 + xcd;
  nt = ng * G + (rem - lm * gsz);
  return true;
}

constexpr int NPHASE = 15;

DI void run_phase(PRef p, int ph, char* smem, int noatom) {
  const int nb = gridDim.x, b = blockIdx.x;
  if (ph == 0) { phase_prep(p); return; }
  if (ph == 1) {
    for (int it = b; it < 136; it += nb) memkv_tile(p, it, smem);
    { int mt, nt; for (int k = 0; gemm_tile_at(k, 8, 4, mt, nt); k++) inproj_a_tile(p, 0, mt, nt, smem, noatom); }
    return;
  }
  int layer, sub;
  if (ph <= 4) { layer = 0; sub = ph - 1; }
  else if (ph <= 7) { layer = 1; sub = ph == 5 ? 0 : ph - 4; }
  else if (ph <= 11) { layer = 2; sub = ph - 8; }
  else { layer = 3; sub = ph == 12 ? 0 : ph - 11; }
  const int j = layer >> 1;
  const bool isA = (layer & 1) == 0;
  if (sub == 0) {
    int mt, nt;
    if (isA) for (int k = 0; gemm_tile_at(k, 8, 4, mt, nt); k++) inproj_a_tile(p, layer, mt, nt, smem, noatom);
    else for (int k = 0; gemm_tile_at(k, 11, 4, mt, nt); k++) inproj_b_tile(p, layer, mt, nt, smem, noatom);
  } else if (sub == 1) {
    int mt, nt;
    for (int k = 0; gemm_tile_at(k, 11, 11, mt, nt); k++) upproj_tile(p, layer, mt, nt, smem);
  } else if (sub == 2) {
    if (isA) {
      if ((nb & 7) == 0) {
        const int xj = b & 7, l = b >> 3, nl = nb >> 3;
        for (int li = l; li < 96; li += nl) {
          const int u = xj + 8 * (li >> 5);
          mla_item(p, j, 0, u >> 1, (u & 1) * 32 + (li & 31), smem);
        }
        for (int li = l; li < 384; li += nl) {
          const int u = xj + 8 * (li >> 4);
          mla_item(p, j, 1 + u / 12, u % 12, li & 15, smem);
        }
      } else {
        for (int it = b; it < 768 + 3072; it += nb) {
          if (it < 768) mla_item(p, j, 0, it >> 6, it & 63, smem);
          else { int u = it - 768; int bh = u >> 4; mla_item(p, j, 1 + bh / 12, bh % 12, u & 15, smem); }
        }
      }
      for (int it = b; it < 1280; it += nb) memattn_item(p, layer, it >> 2, it & 3, smem);
    } else {
      for (int it = b; it < 2560 + 1280; it += nb) {
        if (it < 2560) sgu_item(p, j, it, smem);
        else { int u = it - 2560; memattn_item(p, layer, u >> 2, u & 3, smem); }
      }
    }
  } else {
    int mt, nt;
    for (int k = 0; gemm_tile_at(k, 4, 4, mt, nt); k++) outproj_tile(p, layer, mt, nt, smem, noatom);
  }
}

__global__ void __launch_bounds__(512, 2) mega(Params p_, int ph_lo, int ph_hi, int coop) {
  __shared__ __attribute__((aligned(16))) char smem[SMEM_BYTES];
  PRef p = *(const __attribute__((address_space(4))) Params*)__builtin_amdgcn_kernarg_segment_ptr();
  for (int ph = ph_lo; ph < ph_hi; ph++) {
    run_phase(p, ph, smem, 0);
    if (coop && ph + 1 < ph_hi) cg::this_grid().sync();
#if DUPMASK
    if ((DUPMASK >> ph) & 1) { run_phase(p, ph, smem, 1); cg::this_grid().sync(); }
#endif
  }
}

#ifndef MULTI_LAUNCH
#define MULTI_LAUNCH 0
#endif

extern "C" void kernel_launch(void* const* d_in, const int* in_sizes, int n_in, void* d_out, int out_size, void* d_ws,
                              size_t ws_size, hipStream_t stream) {
  static int grid_blocks = 0;
  if (!grid_blocks) {
    int dev = 0, cus = 0, per_cu = 0;
    hipGetDevice(&dev);
    hipDeviceGetAttribute(&cus, hipDeviceAttributeMultiprocessorCount, dev);
    hipOccupancyMaxActiveBlocksPerMultiprocessor(&per_cu, mega, 512, 0);
    if (per_cu > 1) per_cu = 1;
    if (per_cu < 1) per_cu = 1;
    grid_blocks = (cus * per_cu) & ~7;
  }
  Params p{};
  for (int i = 0; i < 21; i++) p.in[i] = (const float*)d_in[i];
  p.out = (float*)d_out;
  p.ws = (char*)d_ws;
  if (ws_size < WS_TOTAL) { fprintf(stderr, "workspace too small: %zu < %zu\n", ws_size, (size_t)WS_TOTAL); }
#if MULTI_LAUNCH
  for (int ph = 0; ph < NPHASE; ph++) {
    hipLaunchKernelGGL(mega, dim3(grid_blocks), dim3(512), 0, stream, p, ph, ph + 1, 0);
  }
#else
  int lo = 0, hi = NPHASE, coop = 1;
  void* args[] = {&p, &lo, &hi, &coop};
  hipError_t e = hipLaunchCooperativeKernel((void*)mega, dim3(grid_blocks), dim3(512), args, 0, stream);
  if (e != hipSuccess) fprintf(stderr, "cooperative launch failed: %s (grid %d)\n", hipGetErrorString(e), grid_blocks);
#endif
}
```
